# Optimizing an MI355X kernel written in HIP

```python
import jax, jax.numpy as jnp
from jax import lax
import numpy as np

D_MODEL = 2048
BATCH = 2
SEQ = 8192
DEPTH = 1
DEC_BATCH = 32
DEC_SEQ = 4
PAST_LEN = 16384
PAGE_SIZE = 128

HEAD_DIM = 128
N_HEADS = 8
GROUPS = ((128, 1), (512, 4), (2048, 16))
N_GROUPS = 3
N_OFFSETS = 129
MAX_OFFSET = N_OFFSETS - 1
BAND = 128
D_ATT = N_HEADS * HEAD_DIM
D_CONV = D_MODEL
CONV_WIDTH = 3
ROT_DIM = HEAD_DIM // 4
ROPE_THETA = 500000.0
EPS = 1e-6
SCALE = HEAD_DIM ** -0.5
NEG_INF = -1e30

QKV_COLS = N_GROUPS * 3 * D_ATT
OFF_AGATE = QKV_COLS
OFF_CONV = OFF_AGATE + D_ATT
OFF_CGATE = OFF_CONV + 3 * D_CONV
OFF_MERGE = OFF_CGATE + D_CONV
D_IN_TOTAL = OFF_MERGE + 2 * D_MODEL

kernel_name = "dilated_swa_shortconv_gated_hybrid_step"


def _rmsnorm(x, g):
    x32 = x.astype(jnp.float32)
    y = x32 * lax.rsqrt(jnp.mean(x32 * x32, axis=-1, keepdims=True) + EPS)
    return (y * g.astype(jnp.float32)).astype(x.dtype)


def _rope(x, pos):
    half = ROT_DIM // 2
    inv = ROPE_THETA ** (-jnp.arange(half, dtype=jnp.float32) * (2.0 / ROT_DIM))
    ang = pos[:, None] * inv[None, :]
    cos = jnp.cos(ang)[None, :, None, :]
    sin = jnp.sin(ang)[None, :, None, :]
    x32 = x.astype(jnp.float32)
    x1, x2, rest = x32[..., :half], x32[..., half:ROT_DIM], x32[..., ROT_DIM:]
    return jnp.concatenate([x1 * cos - x2 * sin, x2 * cos + x1 * sin, rest], axis=-1).astype(x.dtype)


def _softmax_stats(s):
    m = jnp.max(s, axis=-1, keepdims=True)
    p = jnp.exp(s - m)
    l = jnp.sum(p, axis=-1, keepdims=True)
    return p / l, (m + jnp.log(l))[..., 0]


def _mixer_inputs(x, pos, norm_w, w_in, q_norm_w, k_norm_w):
    b, s, _ = x.shape
    z = _rmsnorm(x, norm_w) @ w_in
    qkv = z[..., :QKV_COLS].reshape(b, s, N_GROUPS, 3, N_HEADS, HEAD_DIM)
    q = _rmsnorm(qkv[:, :, :, 0], q_norm_w[:, None, :]).reshape(b, s, N_GROUPS * N_HEADS, HEAD_DIM)
    k = _rmsnorm(qkv[:, :, :, 1], k_norm_w[:, None, :]).reshape(b, s, N_GROUPS * N_HEADS, HEAD_DIM)
    q, k = _rope(q, pos), _rope(k, pos)
    v = qkv[:, :, :, 2]
    qs = [q[:, :, g * N_HEADS:(g + 1) * N_HEADS] for g in range(N_GROUPS)]
    ks = [k[:, :, g * N_HEADS:(g + 1) * N_HEADS] for g in range(N_GROUPS)]
    vs = [v[:, :, g] for g in range(N_GROUPS)]
    a_gate = z[..., OFF_AGATE:OFF_CONV]
    h_c = z[..., OFF_CONV:OFF_CONV + D_CONV]
    b_c = z[..., OFF_CONV + D_CONV:OFF_CONV + 2 * D_CONV]
    c_c = z[..., OFF_CONV + 2 * D_CONV:OFF_CGATE]
    c_gate = z[..., OFF_CGATE:OFF_MERGE]
    merge_logits = z[..., OFF_MERGE:]
    return qs, ks, vs, a_gate, h_c, b_c, c_c, c_gate, merge_logits


def _dilated_band_attention(q, k, v, dilation):
    b, s, h, dh = q.shape
    L = s // dilation
    nb = -(-L // BAND)
    lp = nb * BAND
    n = b * dilation

    def to_sub(x):
        x = x.reshape(b, L, dilation, h, dh).transpose(0, 2, 1, 3, 4).reshape(n, L, h, dh)
        return jnp.pad(x, ((0, 0), (0, lp - L), (0, 0), (0, 0)))

    def band_keys(x):
        xp = jnp.pad(to_sub(x), ((0, 0), (BAND, 0), (0, 0), (0, 0)))
        prev = xp[:, :lp].reshape(n, nb, BAND, h, dh)
        cur = xp[:, BAND:].reshape(n, nb, BAND, h, dh)
        return jnp.concatenate([prev, cur], axis=2)

    qb = to_sub(q).reshape(n, nb, BAND, h, dh)
    kb, vb = band_keys(k), band_keys(v)
    sc = jnp.einsum('nbqhd,nbkhd->nbhqk', qb, kb).astype(jnp.float32) * SCALE
    qi = jnp.arange(BAND)[:, None]
    kj = jnp.arange(2 * BAND)[None, :]
    dist = qi + BAND - kj
    key_idx = jnp.arange(nb)[:, None, None] * BAND - BAND + kj[None]
    mask = ((dist >= 0) & (dist <= MAX_OFFSET))[None] & (key_idx >= 0)
    sc = jnp.where(mask[None, :, None], sc, NEG_INF)
    p, lse = _softmax_stats(sc)
    o = jnp.einsum('nbhqk,nbkhd->nbqhd', p.astype(v.dtype), vb)
    o = o.reshape(n, lp, h, dh)[:, :L].reshape(b, dilation, L, h, dh).transpose(0, 2, 1, 3, 4).reshape(b, s, h, dh)
    lse = lse.transpose(0, 1, 3, 2).reshape(n, lp, h)[:, :L].reshape(b, dilation, L, h).transpose(0, 2, 1, 3).reshape(b, s, h)
    return o, lse


def _dilated_gather_attention(q, k_ext, v_ext, dilation):
    t = q.shape[1]
    lb = k_ext.shape[1] - t
    idx = lb + jnp.arange(t)[:, None] - jnp.arange(N_OFFSETS)[None, :] * dilation
    valid = idx >= 0
    idx = jnp.maximum(idx, 0)
    kg = k_ext[:, idx]
    vg = v_ext[:, idx]
    sc = jnp.einsum('bthd,btjhd->bthj', q, kg).astype(jnp.float32) * SCALE
    sc = jnp.where(valid[None, :, None, :], sc, NEG_INF)
    p, lse = _softmax_stats(sc)
    o = jnp.einsum('bthj,btjhd->bthd', p.astype(v_ext.dtype), vg)
    return o, lse


def _combine_groups(outs, lses):
    w = jax.nn.softmax(jnp.stack(lses, axis=0), axis=0)
    return jnp.einsum('gbsh,gbshd->bshd', w.astype(outs[0].dtype), jnp.stack(outs, axis=0))


def _short_conv(u_ext, w):
    L = u_ext.shape[1] - (CONV_WIDTH - 1)
    return sum(w[i] * u_ext[:, i:i + L] for i in range(CONV_WIDTH))


def _merge(x, o_att, a_gate, conv_y, c_gate, merge_logits, w_att_proj, w_conv_proj, w_out):
    b, s, _ = x.shape
    a = (o_att.reshape(b, s, D_ATT) * jax.nn.silu(a_gate)) @ w_att_proj
    c = (conv_y * jax.nn.silu(c_gate)) @ w_conv_proj
    m = jax.nn.sigmoid(merge_logits[..., :D_MODEL]) * a + jax.nn.sigmoid(merge_logits[..., D_MODEL:]) * c
    return x + m @ w_out


def setup_inputs(seed: int = 0) -> dict:
    key = jax.random.key(seed)
    ks = jax.random.split(key, 16)
    f32 = jnp.float32

    def nrm(k, shape, scale):
        return jax.random.normal(k, shape, f32) * scale

    def kv_cache(k, window):
        return nrm(k, (DEPTH, DEC_BATCH, min(window, PAST_LEN), 2, N_HEADS, HEAD_DIM), 1.0)

    return {
        "x_prompt": nrm(ks[0], (BATCH, SEQ, D_MODEL), 1.0),
        "x_sample": nrm(ks[1], (DEC_BATCH, DEC_SEQ, D_MODEL), 1.0),
        "cache_kv_w128": kv_cache(ks[2], GROUPS[0][0]),
        "cache_kv_w512": kv_cache(ks[3], GROUPS[1][0]),
        "cache_kv_w2048": kv_cache(ks[4], GROUPS[2][0]),
        "state_conv": nrm(ks[5], (DEPTH, DEC_BATCH, CONV_WIDTH - 1, D_CONV), 1.0),
        "norm_w": 1.0 + nrm(ks[6], (DEPTH, D_MODEL), 0.1),
        "w_in": nrm(ks[7], (DEPTH, D_MODEL, D_IN_TOTAL), D_MODEL ** -0.5),
        "q_norm_w": 1.0 + nrm(ks[8], (DEPTH, N_GROUPS, HEAD_DIM), 0.1),
        "k_norm_w": 1.0 + nrm(ks[9], (DEPTH, N_GROUPS, HEAD_DIM), 0.1),
        "conv_w": nrm(ks[10], (DEPTH, CONV_WIDTH, D_CONV), CONV_WIDTH ** -0.5),
        "w_att_proj": nrm(ks[11], (DEPTH, D_ATT, D_MODEL), D_ATT ** -0.5),
        "w_conv_proj": nrm(ks[12], (DEPTH, D_CONV, D_MODEL), D_CONV ** -0.5),
        "w_out": nrm(ks[13], (DEPTH, D_MODEL, D_MODEL), D_MODEL ** -0.5),
    }


def reference(x_prompt, x_sample, cache_kv_w128, cache_kv_w512, cache_kv_w2048, state_conv,
              norm_w, w_in, q_norm_w, k_norm_w, conv_w, w_att_proj, w_conv_proj, w_out):
    caches = (cache_kv_w128, cache_kv_w512, cache_kv_w2048)
    s_p = x_prompt.shape[1]
    t_s = x_sample.shape[1]
    pos_p = jnp.arange(s_p, dtype=jnp.float32)
    pos_s = PAST_LEN + jnp.arange(t_s, dtype=jnp.float32)

    yp, ys = x_prompt, x_sample
    kv_p = [[] for _ in GROUPS]
    kv_s = [[] for _ in GROUPS]
    conv_p, conv_s = [], []
    for l in range(DEPTH):
        lw = (norm_w[l], w_in[l], q_norm_w[l], k_norm_w[l])
        pw = (w_att_proj[l], w_conv_proj[l], w_out[l])

        qs, ks, vs, a_gate, h_c, b_c, c_c, c_gate, mlog = _mixer_inputs(yp, pos_p, *lw)
        outs, lses = [], []
        for g, (window, dil) in enumerate(GROUPS):
            o, lse = _dilated_band_attention(qs[g], ks[g], vs[g], dil)
            outs.append(o)
            lses.append(lse)
            keep = min(window, s_p)
            kv_p[g].append(jnp.stack([ks[g][:, -keep:], vs[g][:, -keep:]], axis=2))
        o_att = _combine_groups(outs, lses)
        u_ext = jnp.pad(c_c * h_c, ((0, 0), (CONV_WIDTH - 1, 0), (0, 0)))
        conv_y = b_c * _short_conv(u_ext, conv_w[l])
        conv_p.append(u_ext[:, -(CONV_WIDTH - 1):])
        yp_next = _merge(yp, o_att, a_gate, conv_y, c_gate, mlog, *pw)

        qs, ks, vs, a_gate, h_c, b_c, c_c, c_gate, mlog = _mixer_inputs(ys, pos_s, *lw)
        outs, lses = [], []
        for g, (window, dil) in enumerate(GROUPS):
            buf = caches[g][l]
            k_ext = jnp.concatenate([buf[:, :, 0], ks[g]], axis=1)
            v_ext = jnp.concatenate([buf[:, :, 1], vs[g]], axis=1)
            o, lse = _dilated_gather_attention(qs[g], k_ext, v_ext, dil)
            outs.append(o)
            lses.append(lse)
            keep = min(window, buf.shape[1] + t_s)
            kv_s[g].append(jnp.stack([k_ext[:, -keep:], v_ext[:, -keep:]], axis=2))
        o_att = _combine_groups(outs, lses)
        u_ext = jnp.concatenate([state_conv[l], c_c * h_c], axis=1)
        conv_y = b_c * _short_conv(u_ext, conv_w[l])
        conv_s.append(u_ext[:, -(CONV_WIDTH - 1):])
        ys_next = _merge(ys, o_att, a_gate, conv_y, c_gate, mlog, *pw)

        yp, ys = yp_next, ys_next

    new_kv_w128_prompt = jnp.stack(kv_p[0], axis=0)
    new_kv_w512_prompt = jnp.stack(kv_p[1], axis=0)
    new_kv_w2048_prompt = jnp.stack(kv_p[2], axis=0)
    new_conv_prompt = jnp.stack(conv_p, axis=0)
    new_kv_w128_sample = jnp.stack(kv_s[0], axis=0)
    new_kv_w512_sample = jnp.stack(kv_s[1], axis=0)
    new_kv_w2048_sample = jnp.stack(kv_s[2], axis=0)
    new_conv_sample = jnp.stack(conv_s, axis=0)
    return (yp, ys, new_kv_w128_prompt, new_kv_w512_prompt, new_kv_w2048_prompt, new_conv_prompt,
            new_kv_w128_sample, new_kv_w512_sample, new_kv_w2048_sample, new_conv_sample)
```

```cpp
#include <hip/hip_runtime.h>
#include <hip/hip_cooperative_groups.h>
#include <cstdio>
namespace cg = cooperative_groups;
namespace pg8 {
#define PG8_LAS __attribute__((address_space(3)))
typedef unsigned short bf16_t;
typedef short bf16x8 __attribute__((ext_vector_type(8)));
typedef float f32x4 __attribute__((ext_vector_type(4)));
typedef unsigned u32x4 __attribute__((ext_vector_type(4)));
constexpr int BM = 256, BK = 64, HALF = 128, HTB = HALF * BK * 2  , STAGE_BYTES = 8 * HTB, NXCD = 8, WGM = 8;

__host__ __device__ __forceinline__ int lds_byte(int r, int c) { const int st = (r >> 4) * 2 + (c >> 5), rr = r & 15, cc = c & 31, ob = rr * 64 + cc * 2; return st * 1024 + (ob ^ (((ob >> 9) & 1) << 5)); }
__host__ __device__ __forceinline__ void stage_rc(int b, int& R, int& C) { const int st = b / 1024, sb = b % 1024, swz = sb ^ (((sb >> 9) & 1) << 5); R = (st >> 1) * 16 + swz / 64; C = (st & 1) * 32 + (swz % 64) / 2; }
__host__ __device__ __forceinline__ int perm32(int rho) { const int n = rho >> 4, i = rho & 15; return 8 * (i >> 2) + 4 * n + (i & 3); }

struct Unit { int pm, pn; };
struct Gemm { const bf16_t* A; const bf16_t* Bt; int M, N, K; };

struct StaticOrder {
    int nM, nN, nwg, G, c;
    __host__ __device__ void init(int M, int N, int G_, int c_) { nM = M / BM; nN = N / BM; nwg = nM * nN; G = G_; c = c_; }
    __host__ __device__ bool next(int i, Unit& u) const {
        const long L = (long)i * G + c; if (L >= nwg) return false;
        int wgid = (int)L; { const int q = nwg / NXCD, r = nwg % NXCD, xcd = wgid % NXCD, off = wgid / NXCD; wgid = (xcd < r ? xcd * (q + 1) : r * (q + 1) + (xcd - r) * q) + off; }
        const int nig = WGM * nN, gid = wgid / nig, fm = gid * WGM, gsz = (nM - fm) < WGM ? (nM - fm) : WGM;
        u.pm = fm + ((wgid % nig) % gsz); u.pn = (wgid % nig) / gsz; return true;
    }
    __device__ __forceinline__ void a_ready(const Unit&) const {}
    __device__ __forceinline__ void done(const Unit&) const {}
};
typedef __bf16 bf16x2_t __attribute__((ext_vector_type(2)));
typedef float f32x2_t __attribute__((ext_vector_type(2)));
__device__ __forceinline__ unsigned cvt_pk_bf16(float lo, float hi) { const f32x2_t f = {lo, hi}; return __builtin_bit_cast(unsigned, __builtin_convertvector(f, bf16x2_t)); }
__device__ __forceinline__ float bf_lo(unsigned u) { return __uint_as_float(u << 16); }
__device__ __forceinline__ float bf_hi(unsigned u) { return __uint_as_float(u & 0xffff0000u); }
__device__ __forceinline__ float sigm(float x) { return 1.0f / (1.0f + __expf(-x)); }

struct EpiZ {
    static constexpr bool PERM = true, AFTER_DRAIN = false;
    bf16_t* O; int ldc;
    __device__ __forceinline__ void operator()(const f32x4 (&acc)[2][2][4][2], const Unit& u, int wr, int wc, int fr, int fq) const {
        const int row0 = u.pm * BM + wr * 64 + fr, col0 = u.pn * BM + wc * 32 + 8 * fq;
#pragma unroll
        for (int ai = 0; ai < 2; ++ai)
#pragma unroll
            for (int m = 0; m < 4; ++m) { bf16_t* rowp = O + (size_t)(row0 + ai * HALF + m * 16) * ldc + col0;
#pragma unroll
                for (int bj = 0; bj < 2; ++bj) { const f32x4 v0 = acc[ai][bj][m][0], v1 = acc[ai][bj][m][1];
                    u32x4 w; w.x = cvt_pk_bf16(v0[0], v0[1]); w.y = cvt_pk_bf16(v0[2], v0[3]); w.z = cvt_pk_bf16(v1[0], v1[1]); w.w = cvt_pk_bf16(v1[2], v1[3]);
                    *(u32x4*)(rowp + bj * HALF) = w; } }
    }
};
struct EpiT {
    static constexpr bool PERM = true, AFTER_DRAIN = false;
    float* T; int ldt; const bf16_t* Z; int ldz; int zoff;
    __device__ __forceinline__ void operator()(const f32x4 (&acc)[2][2][4][2], const Unit& u, int wr, int wc, int fr, int fq) const {
        const int row0 = u.pm * BM + wr * 64 + fr, col0 = u.pn * BM + wc * 32 + 8 * fq;
#pragma unroll
        for (int ai = 0; ai < 2; ++ai)
#pragma unroll
            for (int m = 0; m < 4; ++m) { const int row = row0 + ai * HALF + m * 16;
#pragma unroll
                for (int bj = 0; bj < 2; ++bj) { const int col = col0 + bj * HALF;
                    const u32x4 lg = *(const u32x4*)(Z + (size_t)row * ldz + zoff + col);
                    const f32x4 v0 = acc[ai][bj][m][0], v1 = acc[ai][bj][m][1];
                    f32x4 o0, o1;
                    o0[0] = sigm(bf_lo(lg.x)) * v0[0]; o0[1] = sigm(bf_hi(lg.x)) * v0[1]; o0[2] = sigm(bf_lo(lg.y)) * v0[2]; o0[3] = sigm(bf_hi(lg.y)) * v0[3];
                    o1[0] = sigm(bf_lo(lg.z)) * v1[0]; o1[1] = sigm(bf_hi(lg.z)) * v1[1]; o1[2] = sigm(bf_lo(lg.w)) * v1[2]; o1[3] = sigm(bf_hi(lg.w)) * v1[3];
                    float* tp = T + (size_t)row * ldt + col;
                    *(f32x4*)tp = o0; *(f32x4*)(tp + 4) = o1; } }
    }
};
struct EpiM {
    static constexpr bool PERM = true, AFTER_DRAIN = false;
    const float* T; int ldt; bf16_t* MB; int ldm; const bf16_t* Z; int ldz; int zoff;
    __device__ __forceinline__ void operator()(const f32x4 (&acc)[2][2][4][2], const Unit& u, int wr, int wc, int fr, int fq) const {
        const int row0 = u.pm * BM + wr * 64 + fr, col0 = u.pn * BM + wc * 32 + 8 * fq;
#pragma unroll
        for (int ai = 0; ai < 2; ++ai)
#pragma unroll
            for (int m = 0; m < 4; ++m) { const int row = row0 + ai * HALF + m * 16;
#pragma unroll
                for (int bj = 0; bj < 2; ++bj) { const int col = col0 + bj * HALF;
                    const u32x4 lg = *(const u32x4*)(Z + (size_t)row * ldz + zoff + col);
                    const float* tp = T + (size_t)row * ldt + col;
                    const f32x4 t0 = *(const f32x4*)tp, t1 = *(const f32x4*)(tp + 4);
                    const f32x4 v0 = acc[ai][bj][m][0], v1 = acc[ai][bj][m][1];
                    f32x4 o0, o1;
                    o0[0] = t0[0] + sigm(bf_lo(lg.x)) * v0[0]; o0[1] = t0[1] + sigm(bf_hi(lg.x)) * v0[1]; o0[2] = t0[2] + sigm(bf_lo(lg.y)) * v0[2]; o0[3] = t0[3] + sigm(bf_hi(lg.y)) * v0[3];
                    o1[0] = t1[0] + sigm(bf_lo(lg.z)) * v1[0]; o1[1] = t1[1] + sigm(bf_hi(lg.z)) * v1[1]; o1[2] = t1[2] + sigm(bf_lo(lg.w)) * v1[2]; o1[3] = t1[3] + sigm(bf_hi(lg.w)) * v1[3];
                    u32x4 w; w.x = cvt_pk_bf16(o0[0], o0[1]); w.y = cvt_pk_bf16(o0[2], o0[3]); w.z = cvt_pk_bf16(o1[0], o1[1]); w.w = cvt_pk_bf16(o1[2], o1[3]);
                    *(u32x4*)(MB + (size_t)row * ldm + col) = w; } }
    }
};
struct EpiY {
    static constexpr bool PERM = false, AFTER_DRAIN = false;
    const float* xp; const float* xs; float* yp; float* ys; int np, ns, ld;
    __device__ __forceinline__ void operator()(const f32x4 (&acc)[2][2][4][2], const Unit& u, int wr, int wc, int fr, int fq) const {
        const int row0 = u.pm * BM + wr * 64 + fr, col0 = u.pn * BM + wc * 32 + 4 * fq;
#pragma unroll
        for (int ai = 0; ai < 2; ++ai)
#pragma unroll
            for (int m = 0; m < 4; ++m) { const int row = row0 + ai * HALF + m * 16;
                const float* src; float* dst;
                if (row < np) { src = xp + (size_t)row * ld; dst = yp + (size_t)row * ld; }
                else if (row < np + ns) { src = xs + (size_t)(row - np) * ld; dst = ys + (size_t)(row - np) * ld; }
                else continue;
#pragma unroll
                for (int bj = 0; bj < 2; ++bj)
#pragma unroll
                    for (int n = 0; n < 2; ++n) { const int c = col0 + bj * HALF + n * 16; *(f32x4*)(dst + c) = *(const f32x4*)(src + c) + acc[ai][bj][m][n]; } }
    }
};

template <class Epi, class Sched, bool STAMP = false>
__device__ __forceinline__ void gemm_phase(PG8_LAS unsigned char* lds, const Gemm g, const Sched& S, const Epi& E, unsigned long long* stamps) {
    const int tid = threadIdx.x, wid = __builtin_amdgcn_readfirstlane(tid >> 6), lane = tid & 63, wr = wid >> 2, wc = wid & 3, fr = lane & 15, fq = lane >> 4;
    const int K = g.K, nt = K / BK;
    int ts_lo = 0, ts_hi = 0, nts = 0; const unsigned long long rt_entry = STAMP ? (unsigned long long)wall_clock64() : 0ull;
#define PG8_STAMP() do { if (STAMP && wid == 0 && nts < 64) { const unsigned long long _c = (unsigned long long)clock64(); \
        ts_lo = (lane == nts) ? (int)(unsigned)_c : ts_lo; ts_hi = (lane == nts) ? (int)(unsigned)(_c >> 32) : ts_hi; ++nts; } } while (0)
    PG8_STAMP();
    unsigned voffA[2], voffB[2];
#pragma unroll
    for (int i = 0; i < 2; ++i) { int R, C; stage_rc(tid * 16 + i * 8192, R, C); const int Rb = Epi::PERM ? ((R & ~31) + perm32(R & 31)) : R;
        voffA[i] = (unsigned)(R * K + C) * 2u; voffB[i] = (unsigned)(Rb * K + C) * 2u; }
    const size_t kstep = (size_t)(BK * 2);
    const size_t hstep = (size_t)HALF * K * 2;
    const size_t tstep = 2 * hstep;
    const unsigned ldsw = (unsigned)wid * 1024u;
    const int aoff = lds_byte(wr * 64 + fr, fq * 8), boff = lds_byte(wc * 32 + fr, fq * 8);
#define PG8_SA(b, h) (((b) * 2 + (h)) * HTB)
#define PG8_SB(b, h) ((4 + (b) * 2 + (h)) * HTB)
#define PG8_STAGE(bufoff, gbase, voff) do { _Pragma("unroll") for (int _i = 0; _i < 2; ++_i) \
        __builtin_amdgcn_global_load_lds((const unsigned*)((const char*)(gbase) + (voff)[_i]), (PG8_LAS unsigned*)(lds + (bufoff) + ldsw + _i * 8192), 16, 0, 0); } while (0)
#define PG8_LDA(dst, b, h) do { _Pragma("unroll") for (int m = 0; m < 4; ++m) _Pragma("unroll") for (int k = 0; k < 2; ++k) dst[m][k] = *(const PG8_LAS bf16x8*)(lds + PG8_SA(b, h) + aoff + m * 2048 + k * 1024); } while (0)
#define PG8_LDB(dst, b, h) do { _Pragma("unroll") for (int n = 0; n < 2; ++n) _Pragma("unroll") for (int k = 0; k < 2; ++k) dst[n][k] = *(const PG8_LAS bf16x8*)(lds + PG8_SB(b, h) + boff + n * 2048 + k * 1024); } while (0)
#define PG8_MMA(ai, bj, At, Bt) do { __builtin_amdgcn_s_setprio(1); _Pragma("unroll") for (int m = 0; m < 4; ++m) _Pragma("unroll") for (int n = 0; n < 2; ++n) _Pragma("unroll") for (int k = 0; k < 2; ++k) \
        acc[ai][bj][m][n] = __builtin_amdgcn_mfma_f32_16x16x32_bf16(Bt[n][k], At[m][k], acc[ai][bj][m][n], 0, 0, 0); __builtin_amdgcn_s_setprio(0); } while (0)
#define PG8_WAIT_V(n) asm volatile("s_waitcnt vmcnt(" #n ")" ::: "memory")
#define PG8_WAIT_L(n) asm volatile("s_waitcnt lgkmcnt(" #n ")" ::: "memory")
#define PG8_BAR __builtin_amdgcn_s_barrier()
#define PG8_SCHED __builtin_amdgcn_sched_barrier(0)
    Unit cur, nxt; int ui = 0;
    if (!S.next(0, cur)) return;
    f32x4 acc[2][2][4][2];
#pragma unroll
    for (int a = 0; a < 2; ++a)
#pragma unroll
        for (int b = 0; b < 2; ++b)
#pragma unroll
            for (int m = 0; m < 4; ++m)
#pragma unroll
                for (int n = 0; n < 2; ++n) acc[a][b][m][n] = (f32x4){0.f, 0.f, 0.f, 0.f};
    bf16x8 At[4][2], B0[2][2], B1[2][2];
    const char* cA = (const char*)g.A + (size_t)cur.pm * tstep; const char* cB = (const char*)g.Bt + (size_t)cur.pn * tstep;
    S.a_ready(cur);
    PG8_STAGE(PG8_SB(0, 0), cB, voffB); PG8_STAGE(PG8_SA(0, 0), cA, voffA); PG8_STAGE(PG8_SB(0, 1), cB + hstep, voffB); PG8_STAGE(PG8_SA(0, 1), cA + hstep, voffA);
    if (wr == 1) PG8_BAR;
    PG8_WAIT_V(4); PG8_BAR;
    PG8_STAGE(PG8_SB(1, 0), cB + kstep, voffB); PG8_STAGE(PG8_SA(1, 0), cA + kstep, voffA); PG8_STAGE(PG8_SB(1, 1), cB + hstep + kstep, voffB);
    PG8_WAIT_V(6); PG8_BAR;
    PG8_STAMP();
    for (;;) {
        const bool has_next = S.next(ui + 1, nxt);
        const char* nA = has_next ? (const char*)g.A + (size_t)nxt.pm * tstep : cA; const char* nB = has_next ? (const char*)g.Bt + (size_t)nxt.pn * tstep : cB;
        for (int t = 0; t < nt; t += 2) {
            const bool last = (t == nt - 2);
            const char* a1 = cA + (size_t)(t + 1) * kstep;
            const char* a2 = last ? nA : cA + (size_t)(t + 2) * kstep; const char* b2 = last ? nB : cB + (size_t)(t + 2) * kstep;
            const char* a3 = a2 + kstep; const char* b3 = b2 + kstep;
            if (last && has_next) S.a_ready(nxt);
            PG8_LDB(B0, 0, 0); PG8_SCHED; PG8_LDA(At, 0, 0); PG8_STAGE(PG8_SA(1, 1), a1 + hstep, voffA);
            PG8_WAIT_L(8); PG8_BAR; PG8_WAIT_L(0); PG8_MMA(0, 0, At, B0); PG8_BAR; PG8_SCHED;
            PG8_LDB(B1, 0, 1); PG8_STAGE(PG8_SB(0, 0), b2, voffB);
            PG8_BAR; PG8_WAIT_L(0); PG8_MMA(0, 1, At, B1); PG8_BAR;
            PG8_LDA(At, 0, 1); PG8_STAGE(PG8_SA(0, 0), a2, voffA);
            PG8_BAR; PG8_WAIT_L(0); PG8_MMA(1, 0, At, B0); PG8_BAR; PG8_SCHED;
            PG8_STAGE(PG8_SB(0, 1), b2 + hstep, voffB);
            PG8_WAIT_V(6); PG8_BAR; PG8_MMA(1, 1, At, B1); PG8_BAR;
            PG8_LDB(B0, 1, 0); PG8_SCHED; PG8_LDA(At, 1, 0); PG8_STAGE(PG8_SA(0, 1), a2 + hstep, voffA);
            PG8_WAIT_L(8); PG8_BAR; PG8_WAIT_L(0); PG8_MMA(0, 0, At, B0); PG8_BAR; PG8_SCHED;
            PG8_LDB(B1, 1, 1); PG8_STAGE(PG8_SB(1, 0), b3, voffB);
            PG8_BAR; PG8_WAIT_L(0); PG8_MMA(0, 1, At, B1); PG8_BAR;
            PG8_LDA(At, 1, 1); PG8_STAGE(PG8_SA(1, 0), a3, voffA);
            PG8_BAR; PG8_WAIT_L(0); PG8_MMA(1, 0, At, B0); PG8_BAR; PG8_SCHED;
            PG8_STAGE(PG8_SB(1, 1), b3 + hstep, voffB);
            PG8_WAIT_V(6); PG8_BAR; PG8_MMA(1, 1, At, B1); PG8_BAR;
        }
        PG8_STAMP();
        if constexpr (!Epi::AFTER_DRAIN) { E(acc, cur, wr, wc, fr, fq); S.done(cur); }
        PG8_STAMP();
        if (!has_next) break;
#pragma unroll
        for (int a = 0; a < 2; ++a)
#pragma unroll
            for (int b = 0; b < 2; ++b)
#pragma unroll
                for (int m = 0; m < 4; ++m)
#pragma unroll
                    for (int n = 0; n < 2; ++n) acc[a][b][m][n] = (f32x4){0.f, 0.f, 0.f, 0.f};
        cur = nxt; cA = nA; cB = nB; ++ui;
    }
    PG8_WAIT_V(0);
    if (wr == 0) PG8_BAR;
    PG8_BAR;
    if constexpr (Epi::AFTER_DRAIN) { E.fused(acc, cur, wr, wc, fr, fq, lds, wid, lane); S.done(cur); }
    PG8_STAMP();
    if (STAMP && wid == 0) { stamps[lane] = lane < nts ? (((unsigned long long)(unsigned)ts_hi << 32) | (unsigned)ts_lo) : 0ull;
        if (lane == 62) stamps[62] = rt_entry; if (lane == 63) stamps[63] = (unsigned long long)wall_clock64(); }
#undef PG8_STAMP
#undef PG8_SA
#undef PG8_SB
#undef PG8_STAGE
#undef PG8_LDA
#undef PG8_LDB
#undef PG8_MMA
#undef PG8_WAIT_V
#undef PG8_WAIT_L
#undef PG8_BAR
#undef PG8_SCHED
}
}

using pg8::bf16_t; using pg8::bf16x8; using pg8::f32x4; using pg8::u32x4; using pg8::cvt_pk_bf16; using pg8::bf_lo; using pg8::bf_hi;
typedef unsigned u32x2 __attribute__((ext_vector_type(2)));
typedef float f32x2 __attribute__((ext_vector_type(2)));
#define LAS __attribute__((address_space(3)))
constexpr int NT = 512;
constexpr int DM = 2048, SEQ = 8192, NB = 2, NTOK_P = NB * SEQ, DB = 32, DS = 4, NTOK_S = DB * DS, NTOK = NTOK_P + NTOK_S, M_PAD = 16640;
constexpr int N_IN = 22528, D_ATT = 1024, HD = 128, NH = 8, PAST = 16384;
constexpr int OFF_AGATE = 9216, OFF_CONV = 10240, OFF_CGATE = 16384, OFF_MERGE = 18432;
constexpr float EPS = 1e-6f;
constexpr size_t al256(size_t x) { return (x + 255) & ~(size_t)255; }
constexpr size_t WS_XN = 0;
constexpr size_t WS_WIN = al256(WS_XN + (size_t)M_PAD * DM * 2);
constexpr size_t WS_WATT = al256(WS_WIN + (size_t)N_IN * DM * 2);
constexpr size_t WS_WCONV = al256(WS_WATT + (size_t)DM * D_ATT * 2);
constexpr size_t WS_WOUT = al256(WS_WCONV + (size_t)DM * DM * 2);
constexpr size_t WS_Z = al256(WS_WOUT + (size_t)DM * DM * 2);
constexpr size_t WS_OG = al256(WS_Z + (size_t)M_PAD * N_IN * 2);
constexpr size_t WS_LSE = al256(WS_OG + (size_t)3 * NTOK * D_ATT * 2);
constexpr size_t WS_A1 = al256(WS_LSE + (size_t)3 * NTOK * NH * 4);
constexpr size_t WS_A2 = al256(WS_A1 + (size_t)M_PAD * D_ATT * 2);
constexpr size_t WS_T = al256(WS_A2 + (size_t)M_PAD * DM * 2);
constexpr size_t WS_MB = al256(WS_T + (size_t)M_PAD * DM * 4);
constexpr size_t WS_ROPE = al256(WS_MB + (size_t)M_PAD * DM * 2);
constexpr size_t WS_END = al256(WS_ROPE + (size_t)(SEQ + DS) * 16 * 8);
constexpr size_t O_YP = 0, O_YS = O_YP + (size_t)NTOK_P * DM, O_KVP0 = O_YS + (size_t)NTOK_S * DM, O_KVP1 = O_KVP0 + (size_t)NB * 128 * 2048, O_KVP2 = O_KVP1 + (size_t)NB * 512 * 2048,
                 O_CVP = O_KVP2 + (size_t)NB * 2048 * 2048, O_KVS0 = O_CVP + (size_t)NB * 2 * DM, O_KVS1 = O_KVS0 + (size_t)DB * 128 * 2048, O_KVS2 = O_KVS1 + (size_t)DB * 512 * 2048,
                 O_CVS = O_KVS2 + (size_t)DB * 2048 * 2048, O_END = O_CVS + (size_t)DB * 2 * DM;
constexpr int LDS_BYTES = 139264;
constexpr int KS_STRIDE = 272;
constexpr int VT_STRIDE_DW = 129;
constexpr int VT_OFF = 256 * KS_STRIDE;
static_assert(VT_OFF + 128 * VT_STRIDE_DW * 4 <= LDS_BYTES, "lds");

struct Params {
    const float* x_prompt; const float* x_sample; const float* cache[3]; const float* state_conv; const float* norm_w; const float* w_in; const float* q_norm_w; const float* k_norm_w;
    const float* conv_w; const float* w_att; const float* w_conv; const float* w_out; float* out; unsigned char* ws;
};

typedef const __attribute__((address_space(4))) Params* KP;
__device__ __constant__ float c_rope_inv[16] = {1.000000000e+00f, 4.403665960e-01f, 1.939227432e-01f, 8.539710194e-02f, 3.760603070e-02f, 1.656043902e-02f, 7.292664610e-03f, 3.211445874e-03f,
    1.414213562e-03f, 6.227723788e-04f, 2.742481884e-04f, 1.207697351e-04f, 5.318296098e-05f, 2.341999971e-05f, 1.031338616e-05f, 4.541670478e-06f};

__device__ __forceinline__ float wave_sum(float v) {
#pragma unroll
    for (int o = 32; o >= 1; o >>= 1) v += __shfl_xor(v, o);
    return v;
}
__device__ __forceinline__ float siluf(float x) { return x / (1.0f + __expf(-x)); }

__device__ __forceinline__ void p0_rmsnorm(KP p, int G, int wave, int lane) {
    bf16_t* XN = (bf16_t*)(p->ws + WS_XN);
    for (int row = blockIdx.x * 8 + wave; row < M_PAD; row += G * 8) {
        bf16_t* dst = XN + (size_t)row * DM;
        if (row >= NTOK) {
#pragma unroll
            for (int i = 0; i < 8; ++i) *(u32x2*)(dst + (i * 64 + lane) * 4) = (u32x2){0u, 0u};
            continue;
        }
        const float* src = row < NTOK_P ? p->x_prompt + (size_t)row * DM : p->x_sample + (size_t)(row - NTOK_P) * DM;
        f32x4 v[8]; float ss = 0.f;
#pragma unroll
        for (int i = 0; i < 8; ++i) { v[i] = *(const f32x4*)(src + (i * 64 + lane) * 4); ss += v[i][0] * v[i][0] + v[i][1] * v[i][1] + v[i][2] * v[i][2] + v[i][3] * v[i][3]; }
        ss = wave_sum(ss);
        const float rstd = rsqrtf(ss * (1.0f / DM) + EPS);
#pragma unroll
        for (int i = 0; i < 8; ++i) { const f32x4 w = *(const f32x4*)(p->norm_w + (i * 64 + lane) * 4);
            u32x2 o; o.x = cvt_pk_bf16(v[i][0] * rstd * w[0], v[i][1] * rstd * w[1]); o.y = cvt_pk_bf16(v[i][2] * rstd * w[2], v[i][3] * rstd * w[3]);
            *(u32x2*)(dst + (i * 64 + lane) * 4) = o; }
    }
}
__device__ __forceinline__ void p0_transpose(const float* W, bf16_t* Wt, int K, int N, LAS float* tile, int G, int tid) {
    const int tk = K / 64, tn = N / 64, ntile = tk * tn;
    for (int t = blockIdx.x; t < ntile; t += G) {
        const int k0 = (t % tk) * 64, n0 = (t / tk) * 64;
#pragma unroll
        for (int i = 0; i < 2; ++i) { const int k = (tid >> 4) + 32 * i, n4 = (tid & 15) * 4;
            const f32x4 v = *(const f32x4*)(W + (size_t)(k0 + k) * N + n0 + n4);
            tile[k * 65 + n4 + 0] = v[0]; tile[k * 65 + n4 + 1] = v[1]; tile[k * 65 + n4 + 2] = v[2]; tile[k * 65 + n4 + 3] = v[3]; }
        __syncthreads();
        { const int n = tid >> 3, k8 = (tid & 7) * 8; float f[8];
#pragma unroll
          for (int j = 0; j < 8; ++j) f[j] = tile[(k8 + j) * 65 + n];
          u32x4 o; o.x = cvt_pk_bf16(f[0], f[1]); o.y = cvt_pk_bf16(f[2], f[3]); o.z = cvt_pk_bf16(f[4], f[5]); o.w = cvt_pk_bf16(f[6], f[7]);
          *(u32x4*)(Wt + (size_t)(n0 + n) * K + k0 + k8) = o; }
        __syncthreads();
    }
}
__device__ __forceinline__ void p0_rope(KP p, int G, int tid) {
    f32x2* R = (f32x2*)(p->ws + WS_ROPE);
    for (int i = blockIdx.x * NT + tid; i < (SEQ + DS) * 16; i += G * NT) {
        const int pi = i >> 4, f = i & 15; const float pos = (float)(pi < SEQ ? pi : PAST + (pi - SEQ));
        const float ang = pos * c_rope_inv[f];
        const double t = (double)ang * 0.15915494309189533577; const float fr = (float)(t - rint(t));
        R[i] = (f32x2){__builtin_amdgcn_cosf(fr), __builtin_amdgcn_sinf(fr)};
    }
}
__device__ __forceinline__ void p0_cache_copy(const float* cache, float* out, int W, int G, int tid) {
    const size_t per_b = (size_t)(W - DS) * 512, total = per_b * DB, stride = (size_t)G * NT;
    for (size_t i0 = (size_t)blockIdx.x * NT + tid; i0 < total; i0 += 8 * stride) {
        f32x4 v[8];
#pragma unroll
        for (int u = 0; u < 8; ++u) { const size_t i = i0 + u * stride; if (i < total) { const size_t b = i / per_b, r = i - b * per_b; v[u] = __builtin_nontemporal_load((const f32x4*)cache + (b * W + DS) * 512 + r); } }
#pragma unroll
        for (int u = 0; u < 8; ++u) { const size_t i = i0 + u * stride; if (i < total) { const size_t b = i / per_b, r = i - b * per_b; __builtin_nontemporal_store(v[u], (f32x4*)out + b * W * 512 + r); } }
    }
}

__device__ __forceinline__ void attn_prompt_item(KP p, LAS unsigned char* lds, int item, int tid, int wave, int lane) {
    const bf16_t* Z = (const bf16_t*)(p->ws + WS_Z);
    const f32x2* ROPE = (const f32x2*)(p->ws + WS_ROPE);
    const int h = item & 7, rb = (item >> 3) & 63, b = (item >> 9) & 1, g = item >> 10;
    const int dsh = 2 * g, nb = 64 >> dsh, qb = rb & (nb - 1), r = rb >> (6 - dsh);
    const int W = 128 << dsh;
    const int colQ = ((g * 3 + 0) * NH + h) * HD, colK = ((g * 3 + 1) * NH + h) * HD, colV = ((g * 3 + 2) * NH + h) * HD;
    const bool last = (qb == nb - 1);
    float* okv = p->out + (g == 0 ? O_KVP0 : (g == 1 ? O_KVP1 : O_KVP2));
    const int kbase = qb * 128 - 128;
#pragma unroll 1
    for (int pass = 0; pass < 2; ++pass) {
        const int row = pass * 128 + (tid >> 2), c = tid & 3, kidx = kbase + row;
        const bool valid = kidx >= 0; const int s = valid ? (kidx << dsh) + r : 0;
        float x[32];
        { const u32x4* src = (const u32x4*)(Z + (size_t)(b * SEQ + s) * N_IN + colK + c * 32);
#pragma unroll
          for (int i = 0; i < 4; ++i) { u32x4 v = src[i]; if (!valid) v = (u32x4){0u, 0u, 0u, 0u};
              x[i * 8 + 0] = bf_lo(v.x); x[i * 8 + 1] = bf_hi(v.x); x[i * 8 + 2] = bf_lo(v.y); x[i * 8 + 3] = bf_hi(v.y);
              x[i * 8 + 4] = bf_lo(v.z); x[i * 8 + 5] = bf_hi(v.z); x[i * 8 + 6] = bf_lo(v.w); x[i * 8 + 7] = bf_hi(v.w); } }
        float ss = 0.f;
#pragma unroll
        for (int j = 0; j < 32; ++j) ss += x[j] * x[j];
        ss += __shfl_xor(ss, 1); ss += __shfl_xor(ss, 2);
        const float rstd = rsqrtf(ss * (1.0f / HD) + EPS);
        const float* kw = p->k_norm_w + g * HD + c * 32;
#pragma unroll
        for (int j = 0; j < 32; ++j) x[j] = x[j] * rstd * kw[j];
        if (c == 0) {
#pragma unroll
            for (int i = 0; i < 16; ++i) { const f32x2 cs = ROPE[s * 16 + i]; const float a = x[i], bb = x[i + 16]; x[i] = a * cs.x - bb * cs.y; x[i + 16] = bb * cs.x + a * cs.y; }
        }
        LAS u32x4* kd = (LAS u32x4*)(lds + row * KS_STRIDE + c * 64);
#pragma unroll
        for (int i = 0; i < 4; ++i) { u32x4 o; o.x = cvt_pk_bf16(x[i * 8 + 0], x[i * 8 + 1]); o.y = cvt_pk_bf16(x[i * 8 + 2], x[i * 8 + 3]); o.z = cvt_pk_bf16(x[i * 8 + 4], x[i * 8 + 5]); o.w = cvt_pk_bf16(x[i * 8 + 6], x[i * 8 + 7]); kd[i] = o; }
        if (last && pass == 1) {
            float* d = okv + ((size_t)((b * W + (s - (SEQ - W))) * 2 + 0) * NH + h) * HD + c * 32;
#pragma unroll
            for (int i = 0; i < 8; ++i) *(f32x4*)(d + i * 4) = (f32x4){x[i * 4], x[i * 4 + 1], x[i * 4 + 2], x[i * 4 + 3]};
        }
    }
    LAS unsigned* vt = (LAS unsigned*)(lds + VT_OFF);
#pragma unroll 1
    for (int pass = 0; pass < 4; ++pass) {
        const int dc = (lane & 3) + 4 * (wave & 3), kp = pass * 32 + (wave >> 2) * 16 + (lane >> 2);
        const int kidx = kbase + 2 * kp; const bool valid = kidx >= 0;
        const int s0 = valid ? (kidx << dsh) + r : 0, s1 = valid ? ((kidx + 1) << dsh) + r : 0;
        u32x4 v0 = *(const u32x4*)(Z + (size_t)(b * SEQ + s0) * N_IN + colV + dc * 8);
        u32x4 v1 = *(const u32x4*)(Z + (size_t)(b * SEQ + s1) * N_IN + colV + dc * 8);
        if (!valid) { v0 = (u32x4){0u, 0u, 0u, 0u}; v1 = v0; }
        LAS unsigned* d = vt + (dc * 8) * VT_STRIDE_DW + kp;
        d[0 * VT_STRIDE_DW] = (v0.x & 0xffffu) | (v1.x << 16); d[1 * VT_STRIDE_DW] = (v0.x >> 16) | (v1.x & 0xffff0000u);
        d[2 * VT_STRIDE_DW] = (v0.y & 0xffffu) | (v1.y << 16); d[3 * VT_STRIDE_DW] = (v0.y >> 16) | (v1.y & 0xffff0000u);
        d[4 * VT_STRIDE_DW] = (v0.z & 0xffffu) | (v1.z << 16); d[5 * VT_STRIDE_DW] = (v0.z >> 16) | (v1.z & 0xffff0000u);
        d[6 * VT_STRIDE_DW] = (v0.w & 0xffffu) | (v1.w << 16); d[7 * VT_STRIDE_DW] = (v0.w >> 16) | (v1.w & 0xffff0000u);
        if (last && pass >= 2) {
            float* d0 = okv + ((size_t)((b * W + (s0 - (SEQ - W))) * 2 + 1) * NH + h) * HD + dc * 8;
            float* d1 = okv + ((size_t)((b * W + (s1 - (SEQ - W))) * 2 + 1) * NH + h) * HD + dc * 8;
            *(f32x4*)d0 = (f32x4){bf_lo(v0.x), bf_hi(v0.x), bf_lo(v0.y), bf_hi(v0.y)}; *(f32x4*)(d0 + 4) = (f32x4){bf_lo(v0.z), bf_hi(v0.z), bf_lo(v0.w), bf_hi(v0.w)};
            *(f32x4*)d1 = (f32x4){bf_lo(v1.x), bf_hi(v1.x), bf_lo(v1.y), bf_hi(v1.y)}; *(f32x4*)(d1 + 4) = (f32x4){bf_lo(v1.z), bf_hi(v1.z), bf_lo(v1.w), bf_hi(v1.w)};
        }
    }
    const int fr = lane & 15, fq = lane >> 4;
    const int qi = wave * 16 + fr, sq = ((qb * 128 + qi) << dsh) + r;
    const size_t tokq = (size_t)b * SEQ + sq;
    bf16x8 qf[4];
    { float f[4][8];
      const bf16_t* src = Z + tokq * N_IN + colQ + fq * 8;
      float ss = 0.f;
#pragma unroll
      for (int ks = 0; ks < 4; ++ks) { const u32x4 v = *(const u32x4*)(src + ks * 32);
          f[ks][0] = bf_lo(v.x); f[ks][1] = bf_hi(v.x); f[ks][2] = bf_lo(v.y); f[ks][3] = bf_hi(v.y); f[ks][4] = bf_lo(v.z); f[ks][5] = bf_hi(v.z); f[ks][6] = bf_lo(v.w); f[ks][7] = bf_hi(v.w);
#pragma unroll
          for (int j = 0; j < 8; ++j) ss += f[ks][j] * f[ks][j]; }
      ss += __shfl_xor(ss, 16); ss += __shfl_xor(ss, 32);
      const float rstd = rsqrtf(ss * (1.0f / HD) + EPS);
      const float* qw = p->q_norm_w + g * HD + fq * 8;
#pragma unroll
      for (int ks = 0; ks < 4; ++ks)
#pragma unroll
          for (int j = 0; j < 8; ++j) f[ks][j] = f[ks][j] * rstd * qw[ks * 32 + j];
#pragma unroll
      for (int j = 0; j < 8; ++j) { const float own = f[0][j], oth = __shfl_xor(own, 32); const f32x2 cs = ROPE[sq * 16 + (fq & 1) * 8 + j];
          f[0][j] = (fq < 2) ? own * cs.x - oth * cs.y : own * cs.x + oth * cs.y; }
      const float sc = 0.08838834764831845f * 1.4426950408889634f;
#pragma unroll
      for (int ks = 0; ks < 4; ++ks) { u32x4 o; o.x = cvt_pk_bf16(f[ks][0] * sc, f[ks][1] * sc); o.y = cvt_pk_bf16(f[ks][2] * sc, f[ks][3] * sc); o.z = cvt_pk_bf16(f[ks][4] * sc, f[ks][5] * sc); o.w = cvt_pk_bf16(f[ks][6] * sc, f[ks][7] * sc);
          qf[ks] = __builtin_bit_cast(bf16x8, o); }
    }
    __syncthreads();
    f32x4 sacc[9];
#pragma unroll
    for (int kt = 0; kt < 9; ++kt) { sacc[kt] = (f32x4){0.f, 0.f, 0.f, 0.f};
        const LAS unsigned char* kr = lds + ((wave + kt) * 16 + fr) * KS_STRIDE + fq * 16;
#pragma unroll
        for (int ks = 0; ks < 4; ++ks) { const bf16x8 a = *(const LAS bf16x8*)(kr + ks * 64); sacc[kt] = __builtin_amdgcn_mfma_f32_16x16x32_bf16(a, qf[ks], sacc[kt], 0, 0, 0); }
    }
    float mx = -3.0e38f;
#pragma unroll
    for (int kt = 0; kt < 9; ++kt)
#pragma unroll
        for (int e = 0; e < 4; ++e) { const int kj = (wave + kt) * 16 + fq * 4 + e; const bool ok = (kj >= qi) && (kj <= qi + 128) && (kbase + kj >= 0);
            sacc[kt][e] = ok ? sacc[kt][e] : -3.0e38f; mx = fmaxf(mx, sacc[kt][e]); }
    mx = fmaxf(mx, __shfl_xor(mx, 16)); mx = fmaxf(mx, __shfl_xor(mx, 32));
    float sum = 0.f;
#pragma unroll
    for (int kt = 0; kt < 9; ++kt)
#pragma unroll
        for (int e = 0; e < 4; ++e) { const float pe = (sacc[kt][e] > -1.0e38f) ? __builtin_amdgcn_exp2f(sacc[kt][e] - mx) : 0.f; sacc[kt][e] = pe; sum += pe; }
    sum += __shfl_xor(sum, 16); sum += __shfl_xor(sum, 32);
    const float inv = 1.0f / sum;
    if (fq == 0) ((float*)(p->ws + WS_LSE))[((size_t)g * NTOK + tokq) * NH + h] = (mx + __builtin_amdgcn_logf(sum)) * 0.6931471805599453f;
    bf16x8 pf[5];
#pragma unroll
    for (int kk = 0; kk < 5; ++kk) { u32x4 o; o.x = cvt_pk_bf16(sacc[2 * kk][0] * inv, sacc[2 * kk][1] * inv); o.y = cvt_pk_bf16(sacc[2 * kk][2] * inv, sacc[2 * kk][3] * inv);
        if (kk < 4) { o.z = cvt_pk_bf16(sacc[2 * kk + 1][0] * inv, sacc[2 * kk + 1][1] * inv); o.w = cvt_pk_bf16(sacc[2 * kk + 1][2] * inv, sacc[2 * kk + 1][3] * inv); } else { o.z = 0u; o.w = 0u; }
        pf[kk] = __builtin_bit_cast(bf16x8, o); }
    bf16_t* og = (bf16_t*)(p->ws + WS_OG) + ((size_t)g * NTOK + tokq) * D_ATT + h * HD + fq * 4;
#pragma unroll
    for (int dt = 0; dt < 8; ++dt) { f32x4 oacc = (f32x4){0.f, 0.f, 0.f, 0.f};
        const LAS unsigned* vr = vt + (dt * 16 + fr) * VT_STRIDE_DW + wave * 8 + fq * 2;
#pragma unroll
        for (int kk = 0; kk < 5; ++kk) { u32x4 a; a.x = vr[kk * 16]; a.y = vr[kk * 16 + 1];
            if (kk < 4) { a.z = vr[kk * 16 + 8]; a.w = vr[kk * 16 + 9]; } else { a.z = 0u; a.w = 0u; }
            oacc = __builtin_amdgcn_mfma_f32_16x16x32_bf16(__builtin_bit_cast(bf16x8, a), pf[kk], oacc, 0, 0, 0); }
        u32x2 o; o.x = cvt_pk_bf16(oacc[0], oacc[1]); o.y = cvt_pk_bf16(oacc[2], oacc[3]);
        *(u32x2*)(og + dt * 16) = o; }
    __syncthreads();
}
__device__ __forceinline__ void attn_sample_item(KP p, LAS unsigned char* lds, int item, int tid, int wave, int lane) {
    const bf16_t* Z = (const bf16_t*)(p->ws + WS_Z);
    const f32x2* ROPE = (const f32x2*)(p->ws + WS_ROPE);
    const int h = item & 7, g = (item >> 3) % 3, b = item / 24;
    const int dsh = 2 * g, W = 128 << dsh, dil = 1 << dsh;
    const float* cache = p->cache[g] + (size_t)b * W * 2048;
    float* okv = p->out + (g == 0 ? O_KVS0 : (g == 1 ? O_KVS1 : O_KVS2)) + (size_t)b * W * 2048;
    LAS float* qn = (LAS float*)lds;
    LAS float* kn = qn + 512;
    LAS float* vn = kn + 512;
    LAS float* sc = vn + 512;
    { const int t = wave >> 1, kind = wave & 1; const size_t row = (size_t)NTOK_P + b * DS + t;
      const int col = ((g * 3 + kind) * NH + h) * HD + 2 * lane;
      const unsigned u = *(const unsigned*)(Z + row * N_IN + col);
      float x0 = bf_lo(u), x1 = bf_hi(u);
      const float ss = wave_sum(x0 * x0 + x1 * x1);
      const float rstd = rsqrtf(ss * (1.0f / HD) + EPS);
      const float* nw = (kind == 0 ? p->q_norm_w : p->k_norm_w) + g * HD + 2 * lane;
      x0 = x0 * rstd * nw[0]; x1 = x1 * rstd * nw[1];
      const float o0 = __shfl_xor(x0, 8), o1 = __shfl_xor(x1, 8);
      if (lane < 16) { const int i0 = 2 * (lane & 7); const f32x2 c0 = ROPE[(SEQ + t) * 16 + i0], c1 = ROPE[(SEQ + t) * 16 + i0 + 1];
          if (lane < 8) { x0 = x0 * c0.x - o0 * c0.y; x1 = x1 * c1.x - o1 * c1.y; } else { x0 = x0 * c0.x + o0 * c0.y; x1 = x1 * c1.x + o1 * c1.y; } }
      if (kind == 0) { qn[t * 128 + 2 * lane] = x0 * 0.08838834764831845f; qn[t * 128 + 2 * lane + 1] = x1 * 0.08838834764831845f; }
      else { kn[t * 128 + 2 * lane] = x0; kn[t * 128 + 2 * lane + 1] = x1;
          const unsigned uv = *(const unsigned*)(Z + row * N_IN + ((g * 3 + 2) * NH + h) * HD + 2 * lane);
          const float v0 = bf_lo(uv), v1 = bf_hi(uv);
          vn[t * 128 + 2 * lane] = v0; vn[t * 128 + 2 * lane + 1] = v1;
          float* dk = okv + ((size_t)((W - DS + t) * 2 + 0) * NH + h) * HD + 2 * lane; float* dv = okv + ((size_t)((W - DS + t) * 2 + 1) * NH + h) * HD + 2 * lane;
          *(f32x2*)dk = (f32x2){x0, x1}; *(f32x2*)dv = (f32x2){v0, v1}; }
    }
    __syncthreads();
    { const int sub = lane >> 4, l16 = lane & 15;
      for (int base = wave * 4; base < DS * 129; base += 32) {
          const int pi = base + sub; const bool act = pi < DS * 129; const int pc = act ? pi : 0;
          const int t = pc / 129, j = pc - t * 129; int idx = W + t - j * dil; const bool valid = idx >= 0; idx = idx < 0 ? 0 : idx;
          f32x4 k0, k1;
          if (idx >= W) { const LAS float* kp = kn + (idx - W) * 128 + l16 * 8; k0 = *(const LAS f32x4*)kp; k1 = *(const LAS f32x4*)(kp + 4); }
          else { const float* kp = cache + ((size_t)(idx * 2 + 0) * NH + h) * HD + l16 * 8; k0 = *(const f32x4*)kp; k1 = *(const f32x4*)(kp + 4); }
          const LAS float* qp = qn + t * 128 + l16 * 8; const f32x4 q0 = *(const LAS f32x4*)qp, q1 = *(const LAS f32x4*)(qp + 4);
          float d = k0[0] * q0[0] + k0[1] * q0[1] + k0[2] * q0[2] + k0[3] * q0[3] + k1[0] * q1[0] + k1[1] * q1[1] + k1[2] * q1[2] + k1[3] * q1[3];
          d += __shfl_xor(d, 1); d += __shfl_xor(d, 2); d += __shfl_xor(d, 4); d += __shfl_xor(d, 8);
          if (act && l16 == 0) sc[t * 132 + j] = valid ? d : -1.0e30f;
      }
    }
    __syncthreads();
    if (wave < DS) { const int t = wave;
        const float s0 = sc[t * 132 + lane], s1 = sc[t * 132 + 64 + lane], s2 = (lane == 0) ? sc[t * 132 + 128] : -3.0e38f;
        float mx = fmaxf(fmaxf(s0, s1), s2);
#pragma unroll
        for (int o = 32; o >= 1; o >>= 1) mx = fmaxf(mx, __shfl_xor(mx, o));
        const float e0 = __expf(s0 - mx), e1 = __expf(s1 - mx), e2 = (lane == 0) ? __expf(s2 - mx) : 0.f;
        const float sum = wave_sum(e0 + e1 + e2), inv = 1.0f / sum;
        sc[t * 132 + lane] = e0 * inv; sc[t * 132 + 64 + lane] = e1 * inv; if (lane == 0) sc[t * 132 + 128] = e2 * inv;
        if (lane == 0) ((float*)(p->ws + WS_LSE))[((size_t)g * NTOK + NTOK_P + b * DS + t) * NH + h] = mx + __logf(sum);
    }
    __syncthreads();
    { const int t = tid >> 7, d = tid & 127; float o = 0.f;
      const float* vb = cache + (size_t)(1 * NH + h) * HD + d;
#pragma unroll 8
      for (int j = 0; j < 129; ++j) { int idx = W + t - j * dil; idx = idx < 0 ? 0 : idx;
          const float v = (idx >= W) ? vn[(idx - W) * 128 + d] : vb[(size_t)idx * 2048];
          o += sc[t * 132 + j] * v; }
      bf16_t* og = (bf16_t*)(p->ws + WS_OG) + ((size_t)g * NTOK + NTOK_P + b * DS + t) * D_ATT + h * HD + d;
      const float on = __shfl_down(o, 1);
      if ((lane & 1) == 0) *(unsigned*)og = cvt_pk_bf16(o, on);
    }
    __syncthreads();
}

__device__ __forceinline__ void unpack8(const u32x4 v, float (&f)[8]) { f[0] = bf_lo(v.x); f[1] = bf_hi(v.x); f[2] = bf_lo(v.y); f[3] = bf_hi(v.y); f[4] = bf_lo(v.z); f[5] = bf_hi(v.z); f[6] = bf_lo(v.w); f[7] = bf_hi(v.w); }
__device__ __forceinline__ u32x4 pack8(const float (&f)[8]) { u32x4 o; o.x = cvt_pk_bf16(f[0], f[1]); o.y = cvt_pk_bf16(f[2], f[3]); o.z = cvt_pk_bf16(f[4], f[5]); o.w = cvt_pk_bf16(f[6], f[7]); return o; }
__device__ __forceinline__ void p3_rows(KP p, int G, int wave, int lane) {
    const bf16_t* Z = (const bf16_t*)(p->ws + WS_Z);
    const bf16_t* OG = (const bf16_t*)(p->ws + WS_OG);
    const float* LSE = (const float*)(p->ws + WS_LSE);
    bf16_t* A1 = (bf16_t*)(p->ws + WS_A1); bf16_t* A2 = (bf16_t*)(p->ws + WS_A2);
    for (int row = blockIdx.x * 8 + wave; row < M_PAD; row += G * 8) {
        if (row >= NTOK) {
#pragma unroll
            for (int i = 0; i < 2; ++i) *(u32x4*)(A1 + (size_t)row * D_ATT + (lane + 64 * i) * 8) = (u32x4){0u, 0u, 0u, 0u};
#pragma unroll
            for (int i = 0; i < 4; ++i) *(u32x4*)(A2 + (size_t)row * DM + (lane + 64 * i) * 8) = (u32x4){0u, 0u, 0u, 0u};
            continue;
        }
        const bf16_t* zr = Z + (size_t)row * N_IN;
#pragma unroll
        for (int i = 0; i < 2; ++i) { const int ch = lane + 64 * i, col = ch * 8, h = ch >> 4;
            const float l0 = LSE[((size_t)0 * NTOK + row) * NH + h], l1 = LSE[((size_t)1 * NTOK + row) * NH + h], l2 = LSE[((size_t)2 * NTOK + row) * NH + h];
            const float mx = fmaxf(l0, fmaxf(l1, l2)); float w0 = __expf(l0 - mx), w1 = __expf(l1 - mx), w2 = __expf(l2 - mx); const float inv = 1.0f / (w0 + w1 + w2); w0 *= inv; w1 *= inv; w2 *= inv;
            float o0[8], o1[8], o2[8], ga[8], r[8];
            unpack8(*(const u32x4*)(OG + ((size_t)0 * NTOK + row) * D_ATT + col), o0); unpack8(*(const u32x4*)(OG + ((size_t)1 * NTOK + row) * D_ATT + col), o1);
            unpack8(*(const u32x4*)(OG + ((size_t)2 * NTOK + row) * D_ATT + col), o2); unpack8(*(const u32x4*)(zr + OFF_AGATE + col), ga);
#pragma unroll
            for (int j = 0; j < 8; ++j) r[j] = (w0 * o0[j] + w1 * o1[j] + w2 * o2[j]) * siluf(ga[j]);
            *(u32x4*)(A1 + (size_t)row * D_ATT + col) = pack8(r); }
        const bool samp = row >= NTOK_P; const int pos = samp ? ((row - NTOK_P) & (DS - 1)) : (row & (SEQ - 1)); const int bs = samp ? (row - NTOK_P) >> 2 : row >> 13;
#pragma unroll
        for (int i = 0; i < 4; ++i) { const int col = (lane + 64 * i) * 8;
            float hh[8], cc[8], bb[8], gg[8], u0[8], u1[8], u2[8], r[8];
            unpack8(*(const u32x4*)(zr + OFF_CONV + col), hh); unpack8(*(const u32x4*)(zr + OFF_CONV + 2 * DM + col), cc);
            unpack8(*(const u32x4*)(zr + OFF_CONV + DM + col), bb); unpack8(*(const u32x4*)(zr + OFF_CGATE + col), gg);
#pragma unroll
            for (int j = 0; j < 8; ++j) u0[j] = cc[j] * hh[j];
#pragma unroll
            for (int k = 1; k <= 2; ++k) { float (&uk)[8] = (k == 1) ? u1 : u2;
                if (pos - k >= 0) { float h2[8], c2[8]; unpack8(*(const u32x4*)(zr - (size_t)k * N_IN + OFF_CONV + col), h2); unpack8(*(const u32x4*)(zr - (size_t)k * N_IN + OFF_CONV + 2 * DM + col), c2);
#pragma unroll
                    for (int j = 0; j < 8; ++j) uk[j] = c2[j] * h2[j]; }
                else if (samp) { const float* st = p->state_conv + ((size_t)bs * 2 + (2 + pos - k)) * DM + col; const f32x4 a = *(const f32x4*)st, b2 = *(const f32x4*)(st + 4);
                    uk[0] = a[0]; uk[1] = a[1]; uk[2] = a[2]; uk[3] = a[3]; uk[4] = b2[0]; uk[5] = b2[1]; uk[6] = b2[2]; uk[7] = b2[3]; }
                else {
#pragma unroll
                    for (int j = 0; j < 8; ++j) uk[j] = 0.f; } }
            const float* cw = p->conv_w + col;
#pragma unroll
            for (int j = 0; j < 8; ++j) r[j] = bb[j] * (cw[j] * u2[j] + cw[DM + j] * u1[j] + cw[2 * DM + j] * u0[j]) * siluf(gg[j]);
            *(u32x4*)(A2 + (size_t)row * DM + col) = pack8(r);
            if (pos >= (samp ? DS : SEQ) - 2) {
                float* d = p->out + (samp ? O_CVS : O_CVP) + ((size_t)bs * 2 + (pos - ((samp ? DS : SEQ) - 2))) * DM + col;
                *(f32x4*)d = (f32x4){u0[0], u0[1], u0[2], u0[3]}; *(f32x4*)(d + 4) = (f32x4){u0[4], u0[5], u0[6], u0[7]}; } }
    }
}

#ifndef N_LAUNCHES
#define N_LAUNCHES 1
#endif
struct KArgs { Params p; int ph_lo, ph_hi; };
__global__ void __launch_bounds__(NT, 2) fwd_mega(KArgs a_unused) {
    typedef const __attribute__((address_space(4))) KArgs* KA;
    KA ka = (KA)__builtin_amdgcn_kernarg_segment_ptr();
    KP p = (KP)ka;
    const int lo = ka->ph_lo, hi = ka->ph_hi;
#define RELOAD() asm volatile("" : "+s"(p))
#define IN(k) (lo <= (k) && (k) < hi)
#define GSYNC(k) do { if (IN(k) && IN((k) + 1)) { asm volatile("s_waitcnt vmcnt(0)" ::: "memory"); __builtin_amdgcn_fence(__ATOMIC_RELEASE, "agent"); grid.sync(); __builtin_amdgcn_fence(__ATOMIC_ACQUIRE, "agent"); } RELOAD(); } while (0)
    extern __shared__ __attribute__((aligned(16))) unsigned char lds_raw[];
    LAS unsigned char* lds = (LAS unsigned char*)lds_raw;
    cg::grid_group grid = cg::this_grid();
    const int tid = threadIdx.x, lane = tid & 63, wave = __builtin_amdgcn_readfirstlane(tid >> 6), G = gridDim.x;
    if (IN(0)) {
    p0_rope(p, G, tid);
    p0_rmsnorm(p, G, wave, lane);
    p0_transpose(p->w_in, (bf16_t*)(p->ws + WS_WIN), DM, N_IN, (LAS float*)lds, G, tid);
    p0_transpose(p->w_att, (bf16_t*)(p->ws + WS_WATT), D_ATT, DM, (LAS float*)lds, G, tid);
    p0_transpose(p->w_conv, (bf16_t*)(p->ws + WS_WCONV), DM, DM, (LAS float*)lds, G, tid);
    p0_transpose(p->w_out, (bf16_t*)(p->ws + WS_WOUT), DM, DM, (LAS float*)lds, G, tid);
    p0_cache_copy(p->cache[0], p->out + O_KVS0, 128, G, tid);
    p0_cache_copy(p->cache[1], p->out + O_KVS1, 512, G, tid);
    p0_cache_copy(p->cache[2], p->out + O_KVS2, 2048, G, tid);
    }
    GSYNC(0);
    if (IN(1)) { pg8::Gemm g{(const bf16_t*)(p->ws + WS_XN), (const bf16_t*)(p->ws + WS_WIN), M_PAD, N_IN, DM}; pg8::StaticOrder S; S.init(M_PAD, N_IN, G, (int)blockIdx.x);
      pg8::EpiZ E{(bf16_t*)(p->ws + WS_Z), N_IN};
      pg8::gemm_phase<pg8::EpiZ, pg8::StaticOrder>(lds, g, S, E, nullptr); }
    GSYNC(1);
    if (IN(2)) {
    for (int it = blockIdx.x; it < 3072 + 768; it += G) {
        if (it < 3072) attn_prompt_item(p, lds, it, tid, wave, lane); else attn_sample_item(p, lds, it - 3072, tid, wave, lane);
    }
    }
    GSYNC(2);
    if (IN(3)) p3_rows(p, G, wave, lane);
    GSYNC(3);
    if (IN(4)) { pg8::Gemm g{(const bf16_t*)(p->ws + WS_A1), (const bf16_t*)(p->ws + WS_WATT), M_PAD, DM, D_ATT}; pg8::StaticOrder S; S.init(M_PAD, DM, G, (int)blockIdx.x);
      pg8::EpiT E{(float*)(p->ws + WS_T), DM, (const bf16_t*)(p->ws + WS_Z), N_IN, OFF_MERGE};
      pg8::gemm_phase<pg8::EpiT, pg8::StaticOrder>(lds, g, S, E, nullptr); }
    GSYNC(4);
    if (IN(5)) { pg8::Gemm g{(const bf16_t*)(p->ws + WS_A2), (const bf16_t*)(p->ws + WS_WCONV), M_PAD, DM, DM}; pg8::StaticOrder S; S.init(M_PAD, DM, G, (int)blockIdx.x);
      pg8::EpiM E{(const float*)(p->ws + WS_T), DM, (bf16_t*)(p->ws + WS_MB), DM, (const bf16_t*)(p->ws + WS_Z), N_IN, OFF_MERGE + DM};
      pg8::gemm_phase<pg8::EpiM, pg8::StaticOrder>(lds, g, S, E, nullptr); }
    GSYNC(5);
    if (IN(6)) { pg8::Gemm g{(const bf16_t*)(p->ws + WS_MB), (const bf16_t*)(p->ws + WS_WOUT), M_PAD, DM, DM}; pg8::StaticOrder S; S.init(M_PAD, DM, G, (int)blockIdx.x);
      pg8::EpiY E{p->x_prompt, p->x_sample, p->out + O_YP, p->out + O_YS, NTOK_P, NTOK_S, DM};
      pg8::gemm_phase<pg8::EpiY, pg8::StaticOrder>(lds, g, S, E, nullptr); }
}

extern "C" void kernel_launch(void* const* d_in, const int* in_sizes, int n_in, void* d_out, int out_size, void* d_ws, size_t ws_size, hipStream_t stream) {
    static int grid = 0;
    if (grid == 0) {
        if (n_in != 14 || (size_t)out_size != O_END || ws_size < WS_END) { fprintf(stderr, "kernel_launch: unexpected shapes (n_in %d out %d ws %zu)\n", n_in, out_size, ws_size); grid = -1; return; }
        int dev = 0, cus = 0, per_cu = 0;
        (void)hipGetDevice(&dev); (void)hipDeviceGetAttribute(&cus, hipDeviceAttributeMultiprocessorCount, dev);
        if (hipFuncSetAttribute((const void*)fwd_mega, hipFuncAttributeMaxDynamicSharedMemorySize, LDS_BYTES) != hipSuccess) { fprintf(stderr, "kernel_launch: hipFuncSetAttribute failed\n"); grid = -1; return; }
        if (hipOccupancyMaxActiveBlocksPerMultiprocessor(&per_cu, (const void*)fwd_mega, NT, LDS_BYTES) != hipSuccess || per_cu < 1) { fprintf(stderr, "kernel_launch: occupancy query says %d\n", per_cu); per_cu = 1; }
        (void)hipGetLastError();
        grid = cus * 1;
    }
    if (grid < 0) return;
    KArgs a{};
    Params& p = a.p;
    p.x_prompt = (const float*)d_in[0]; p.x_sample = (const float*)d_in[1]; p.cache[0] = (const float*)d_in[2]; p.cache[1] = (const float*)d_in[3]; p.cache[2] = (const float*)d_in[4];
    p.state_conv = (const float*)d_in[5]; p.norm_w = (const float*)d_in[6]; p.w_in = (const float*)d_in[7]; p.q_norm_w = (const float*)d_in[8]; p.k_norm_w = (const float*)d_in[9];
    p.conv_w = (const float*)d_in[10]; p.w_att = (const float*)d_in[11]; p.w_conv = (const float*)d_in[12]; p.w_out = (const float*)d_in[13]; p.out = (float*)d_out; p.ws = (unsigned char*)d_ws;
    if (N_LAUNCHES == 1) {
        a.ph_lo = 0; a.ph_hi = 7;
        void* args[] = {&a};
        hipError_t e = hipLaunchCooperativeKernel((const void*)fwd_mega, dim3(grid), dim3(NT), args, LDS_BYTES, stream);
        if (e != hipSuccess) fprintf(stderr, "kernel_launch: cooperative launch failed: %s (grid %d)\n", hipGetErrorString(e), grid);
    } else {
        for (int k = 0; k < 7; ++k) { a.ph_lo = k; a.ph_hi = k + 1; hipLaunchKernelGGL(fwd_mega, dim3(grid), dim3(NT), LDS_BYTES, stream, a); }
    }
}
```

```cpp
#include <hip/hip_runtime.h>
#include <hip/hip_cooperative_groups.h>
#include <cstdio>
namespace cg = cooperative_groups;
namespace pg8 {
#define PG8_LAS __attribute__((address_space(3)))
typedef unsigned short bf16_t;
typedef short bf16x8 __attribute__((ext_vector_type(8)));
typedef float f32x4 __attribute__((ext_vector_type(4)));
typedef unsigned u32x4 __attribute__((ext_vector_type(4)));
constexpr int BM = 256, BK = 64, HALF = 128, HTB = HALF * BK * 2  , STAGE_BYTES = 8 * HTB, NXCD = 8, WGM = 8;

__host__ __device__ __forceinline__ int lds_byte(int r, int c) { const int st = (r >> 4) * 2 + (c >> 5), rr = r & 15, cc = c & 31, ob = rr * 64 + cc * 2; return st * 1024 + (ob ^ (((ob >> 9) & 1) << 5)); }
__host__ __device__ __forceinline__ void stage_rc(int b, int& R, int& C) { const int st = b / 1024, sb = b % 1024, swz = sb ^ (((sb >> 9) & 1) << 5); R = (st >> 1) * 16 + swz / 64; C = (st & 1) * 32 + (swz % 64) / 2; }
__host__ __device__ __forceinline__ int perm32(int rho) { const int n = rho >> 4, i = rho & 15; return 8 * (i >> 2) + 4 * n + (i & 3); }

struct Unit { int pm, pn; };
struct Gemm { const bf16_t* A; const bf16_t* Bt; int M, N, K; };

struct StaticOrder {
    int nM, nN, nwg, G, c;
    __host__ __device__ void init(int M, int N, int G_, int c_) { nM = M / BM; nN = N / BM; nwg = nM * nN; G = G_; c = c_; }
    __host__ __device__ bool next(int i, Unit& u) const {
        const long L = (long)i * G + c; if (L >= nwg) return false;
        int wgid = (int)L; { const int q = nwg / NXCD, r = nwg % NXCD, xcd = wgid % NXCD, off = wgid / NXCD; wgid = (xcd < r ? xcd * (q + 1) : r * (q + 1) + (xcd - r) * q) + off; }
        const int nig = WGM * nN, gid = wgid / nig, fm = gid * WGM, gsz = (nM - fm) < WGM ? (nM - fm) : WGM;
        u.pm = fm + ((wgid % nig) % gsz); u.pn = (wgid % nig) / gsz; return true;
    }
    __device__ __forceinline__ void a_ready(const Unit&) const {}
    __device__ __forceinline__ void done(const Unit&) const {}
};
typedef __bf16 bf16x2_t __attribute__((ext_vector_type(2)));
typedef float f32x2_t __attribute__((ext_vector_type(2)));
__device__ __forceinline__ unsigned cvt_pk_bf16(float lo, float hi) { const f32x2_t f = {lo, hi}; return __builtin_bit_cast(unsigned, __builtin_convertvector(f, bf16x2_t)); }
__device__ __forceinline__ float bf_lo(unsigned u) { return __uint_as_float(u << 16); }
__device__ __forceinline__ float bf_hi(unsigned u) { return __uint_as_float(u & 0xffff0000u); }
__device__ __forceinline__ float sigm(float x) { return 1.0f / (1.0f + __expf(-x)); }

struct EpiZ {
    static constexpr bool PERM = true, AFTER_DRAIN = false;
    bf16_t* O; int ldc;
    __device__ __forceinline__ void operator()(const f32x4 (&acc)[2][2][4][2], const Unit& u, int wr, int wc, int fr, int fq) const {
        const int row0 = u.pm * BM + wr * 64 + fr, col0 = u.pn * BM + wc * 32 + 8 * fq;
#pragma unroll
        for (int ai = 0; ai < 2; ++ai)
#pragma unroll
            for (int m = 0; m < 4; ++m) { bf16_t* rowp = O + (size_t)(row0 + ai * HALF + m * 16) * ldc + col0;
#pragma unroll
                for (int bj = 0; bj < 2; ++bj) { const f32x4 v0 = acc[ai][bj][m][0], v1 = acc[ai][bj][m][1];
                    u32x4 w; w.x = cvt_pk_bf16(v0[0], v0[1]); w.y = cvt_pk_bf16(v0[2], v0[3]); w.z = cvt_pk_bf16(v1[0], v1[1]); w.w = cvt_pk_bf16(v1[2], v1[3]);
                    *(u32x4*)(rowp + bj * HALF) = w; } }
    }
};
struct EpiT {
    static constexpr bool PERM = true, AFTER_DRAIN = false;
    bf16_t* T; int ldt; const bf16_t* Z; int ldz; int zoff;
    __device__ __forceinline__ void operator()(const f32x4 (&acc)[2][2][4][2], const Unit& u, int wr, int wc, int fr, int fq) const {
        const int row0 = u.pm * BM + wr * 64 + fr, col0 = u.pn * BM + wc * 32 + 8 * fq;
#pragma unroll
        for (int ai = 0; ai < 2; ++ai)
#pragma unroll
            for (int m = 0; m < 4; ++m) { const int row = row0 + ai * HALF + m * 16;
#pragma unroll
                for (int bj = 0; bj < 2; ++bj) { const int col = col0 + bj * HALF;
                    const u32x4 lg = *(const u32x4*)(Z + (size_t)row * ldz + zoff + col);
                    const f32x4 v0 = acc[ai][bj][m][0], v1 = acc[ai][bj][m][1];
                    u32x4 w;
                    w.x = cvt_pk_bf16(sigm(bf_lo(lg.x)) * v0[0], sigm(bf_hi(lg.x)) * v0[1]); w.y = cvt_pk_bf16(sigm(bf_lo(lg.y)) * v0[2], sigm(bf_hi(lg.y)) * v0[3]);
                    w.z = cvt_pk_bf16(sigm(bf_lo(lg.z)) * v1[0], sigm(bf_hi(lg.z)) * v1[1]); w.w = cvt_pk_bf16(sigm(bf_lo(lg.w)) * v1[2], sigm(bf_hi(lg.w)) * v1[3]);
                    *(u32x4*)(T + (size_t)row * ldt + col) = w; } }
    }
};
struct EpiM {
    static constexpr bool PERM = true, AFTER_DRAIN = false;
    const bf16_t* T; int ldt; bf16_t* MB; int ldm; const bf16_t* Z; int ldz; int zoff;
    __device__ __forceinline__ void operator()(const f32x4 (&acc)[2][2][4][2], const Unit& u, int wr, int wc, int fr, int fq) const {
        const int row0 = u.pm * BM + wr * 64 + fr, col0 = u.pn * BM + wc * 32 + 8 * fq;
#pragma unroll
        for (int ai = 0; ai < 2; ++ai)
#pragma unroll
            for (int m = 0; m < 4; ++m) { const int row = row0 + ai * HALF + m * 16;
#pragma unroll
                for (int bj = 0; bj < 2; ++bj) { const int col = col0 + bj * HALF;
                    const u32x4 lg = *(const u32x4*)(Z + (size_t)row * ldz + zoff + col);
                    const u32x4 tw = *(const u32x4*)(T + (size_t)row * ldt + col);
                    const f32x4 t0 = (f32x4){bf_lo(tw.x), bf_hi(tw.x), bf_lo(tw.y), bf_hi(tw.y)}, t1 = (f32x4){bf_lo(tw.z), bf_hi(tw.z), bf_lo(tw.w), bf_hi(tw.w)};
                    const f32x4 v0 = acc[ai][bj][m][0], v1 = acc[ai][bj][m][1];
                    f32x4 o0, o1;
                    o0[0] = t0[0] + sigm(bf_lo(lg.x)) * v0[0]; o0[1] = t0[1] + sigm(bf_hi(lg.x)) * v0[1]; o0[2] = t0[2] + sigm(bf_lo(lg.y)) * v0[2]; o0[3] = t0[3] + sigm(bf_hi(lg.y)) * v0[3];
                    o1[0] = t1[0] + sigm(bf_lo(lg.z)) * v1[0]; o1[1] = t1[1] + sigm(bf_hi(lg.z)) * v1[1]; o1[2] = t1[2] + sigm(bf_lo(lg.w)) * v1[2]; o1[3] = t1[3] + sigm(bf_hi(lg.w)) * v1[3];
                    u32x4 w; w.x = cvt_pk_bf16(o0[0], o0[1]); w.y = cvt_pk_bf16(o0[2], o0[3]); w.z = cvt_pk_bf16(o1[0], o1[1]); w.w = cvt_pk_bf16(o1[2], o1[3]);
                    *(u32x4*)(MB + (size_t)row * ldm + col) = w; } }
    }
};
struct EpiY {
    static constexpr bool PERM = false, AFTER_DRAIN = false;
    const float* xp; const float* xs; float* yp; float* ys; int np, ns, ld;
    __device__ __forceinline__ void operator()(const f32x4 (&acc)[2][2][4][2], const Unit& u, int wr, int wc, int fr, int fq) const {
        const int row0 = u.pm * BM + wr * 64 + fr, col0 = u.pn * BM + wc * 32 + 4 * fq;
#pragma unroll
        for (int ai = 0; ai < 2; ++ai)
#pragma unroll
            for (int m = 0; m < 4; ++m) { const int row = row0 + ai * HALF + m * 16;
                const float* src; float* dst;
                if (row < np) { src = xp + (size_t)row * ld; dst = yp + (size_t)row * ld; }
                else if (row < np + ns) { src = xs + (size_t)(row - np) * ld; dst = ys + (size_t)(row - np) * ld; }
                else continue;
#pragma unroll
                for (int bj = 0; bj < 2; ++bj)
#pragma unroll
                    for (int n = 0; n < 2; ++n) { const int c = col0 + bj * HALF + n * 16; *(f32x4*)(dst + c) = *(const f32x4*)(src + c) + acc[ai][bj][m][n]; } }
    }
};

struct NoSide { static constexpr bool ON = false; };
struct CopySide {
    static constexpr bool ON = true;
    const float* src0; const float* src1; const float* src2; float* dst0; float* dst1; float* dst2; int q0, qstep, qlim;
    static constexpr int R0 = 32 * 124, R1 = R0 + 32 * 508, R2 = R1 + 32 * 2044;
    __device__ __forceinline__ void rows(int q, const float*& s, float*& d) const {
        if (q < R0) { const int b = q / 124, r = q - b * 124; s = src0 + (size_t)(b * 128 + 4 + r) * 2048; d = dst0 + (size_t)(b * 128 + r) * 2048; }
        else if (q < R1) { const int qq = q - R0, b = qq / 508, r = qq - b * 508; s = src1 + (size_t)(b * 512 + 4 + r) * 2048; d = dst1 + (size_t)(b * 512 + r) * 2048; }
        else { const int qq = q - R1, b = qq / 2044, r = qq - b * 2044; s = src2 + (size_t)(b * 2048 + 4 + r) * 2048; d = dst2 + (size_t)(b * 2048 + r) * 2048; }
    }
};
template <class Epi, class Sched, class Side = NoSide, bool STAMP = false>
__device__ __forceinline__ void gemm_phase(PG8_LAS unsigned char* lds, const Gemm g, const Sched& S, const Epi& E, unsigned long long* stamps, const Side side = Side(), int side_off = 0) {
    const int tid = threadIdx.x, wid = __builtin_amdgcn_readfirstlane(tid >> 6), lane = tid & 63, wr = wid >> 2, wc = wid & 3, fr = lane & 15, fq = lane >> 4;
    const int K = g.K, nt = K / BK;
    int ts_lo = 0, ts_hi = 0, nts = 0; const unsigned long long rt_entry = STAMP ? (unsigned long long)wall_clock64() : 0ull;
#define PG8_STAMP() do { if (STAMP && wid == 0 && nts < 64) { const unsigned long long _c = (unsigned long long)clock64(); \
        ts_lo = (lane == nts) ? (int)(unsigned)_c : ts_lo; ts_hi = (lane == nts) ? (int)(unsigned)(_c >> 32) : ts_hi; ++nts; } } while (0)
    PG8_STAMP();
    unsigned voffA[2], voffB[2];
#pragma unroll
    for (int i = 0; i < 2; ++i) { int R, C; stage_rc(tid * 16 + i * 8192, R, C); const int Rb = Epi::PERM ? ((R & ~31) + perm32(R & 31)) : R;
        voffA[i] = (unsigned)(R * K + C) * 2u; voffB[i] = (unsigned)(Rb * K + C) * 2u; }
    const size_t kstep = (size_t)(BK * 2);
    const size_t hstep = (size_t)HALF * K * 2;
    const size_t tstep = 2 * hstep;
    const unsigned ldsw = (unsigned)wid * 1024u;
    const int aoff = lds_byte(wr * 64 + fr, fq * 8), boff = lds_byte(wc * 32 + fr, fq * 8);
#define PG8_SA(b, h) (((b) * 2 + (h)) * HTB)
#define PG8_SB(b, h) ((4 + (b) * 2 + (h)) * HTB)
#define PG8_STAGE(bufoff, gbase, voff) do { _Pragma("unroll") for (int _i = 0; _i < 2; ++_i) \
        __builtin_amdgcn_global_load_lds((const unsigned*)((const char*)(gbase) + (voff)[_i]), (PG8_LAS unsigned*)(lds + (bufoff) + ldsw + _i * 8192), 16, 0, 0); } while (0)
#define PG8_LDA(dst, b, h) do { _Pragma("unroll") for (int m = 0; m < 4; ++m) _Pragma("unroll") for (int k = 0; k < 2; ++k) dst[m][k] = *(const PG8_LAS bf16x8*)(lds + PG8_SA(b, h) + aoff + m * 2048 + k * 1024); } while (0)
#define PG8_LDB(dst, b, h) do { _Pragma("unroll") for (int n = 0; n < 2; ++n) _Pragma("unroll") for (int k = 0; k < 2; ++k) dst[n][k] = *(const PG8_LAS bf16x8*)(lds + PG8_SB(b, h) + boff + n * 2048 + k * 1024); } while (0)
#define PG8_MMA(ai, bj, At, Bt) do { __builtin_amdgcn_s_setprio(1); _Pragma("unroll") for (int m = 0; m < 4; ++m) _Pragma("unroll") for (int n = 0; n < 2; ++n) _Pragma("unroll") for (int k = 0; k < 2; ++k) \
        acc[ai][bj][m][n] = __builtin_amdgcn_mfma_f32_16x16x32_bf16(Bt[n][k], At[m][k], acc[ai][bj][m][n], 0, 0, 0); __builtin_amdgcn_s_setprio(0); } while (0)
#define PG8_WAIT_V(n) asm volatile("s_waitcnt vmcnt(" #n ")" ::: "memory")
#define PG8_WAIT_L(n) asm volatile("s_waitcnt lgkmcnt(" #n ")" ::: "memory")
#define PG8_BAR __builtin_amdgcn_s_barrier()
#define PG8_SCHED __builtin_amdgcn_sched_barrier(0)
    Unit cur, nxt; int ui = 0;
    int sq_next = 0; float* sd_a = nullptr; float* sd_b = nullptr; f32x4 sv;
    if constexpr (Side::ON) sq_next = side.q0;
#define PG8_SIDE_FILL(slot, dvar) do { if (sq_next < side.qlim) { const float* _s; float* _d; side.rows(sq_next, _s, _d); \
        __builtin_amdgcn_global_load_lds((const unsigned*)(_s + tid * 4), (PG8_LAS unsigned*)(lds + side_off + (slot) * 8192 + ldsw), 16, 0, 0); dvar = _d; sq_next += side.qstep; } else dvar = nullptr; } while (0)
#define PG8_SIDE_READ(slot, dvar) do { if (dvar) sv = *(const PG8_LAS f32x4*)(lds + side_off + (slot) * 8192 + tid * 16); } while (0)
#define PG8_SIDE_STORE(dvar) do { if (dvar) __builtin_nontemporal_store(sv, (f32x4*)dvar + tid); } while (0)
    if (!S.next(0, cur)) return;
    f32x4 acc[2][2][4][2];
#pragma unroll
    for (int a = 0; a < 2; ++a)
#pragma unroll
        for (int b = 0; b < 2; ++b)
#pragma unroll
            for (int m = 0; m < 4; ++m)
#pragma unroll
                for (int n = 0; n < 2; ++n) acc[a][b][m][n] = (f32x4){0.f, 0.f, 0.f, 0.f};
    bf16x8 At[4][2], B0[2][2], B1[2][2];
    const char* cA = (const char*)g.A + (size_t)cur.pm * tstep; const char* cB = (const char*)g.Bt + (size_t)cur.pn * tstep;
    S.a_ready(cur);
    PG8_STAGE(PG8_SB(0, 0), cB, voffB); PG8_STAGE(PG8_SA(0, 0), cA, voffA); PG8_STAGE(PG8_SB(0, 1), cB + hstep, voffB); PG8_STAGE(PG8_SA(0, 1), cA + hstep, voffA);
    if (wr == 1) PG8_BAR;
    PG8_WAIT_V(4); PG8_BAR;
    PG8_STAGE(PG8_SB(1, 0), cB + kstep, voffB); PG8_STAGE(PG8_SA(1, 0), cA + kstep, voffA); PG8_STAGE(PG8_SB(1, 1), cB + hstep + kstep, voffB);
    PG8_WAIT_V(6); PG8_BAR;
    PG8_STAMP();
    for (;;) {
        const bool has_next = S.next(ui + 1, nxt);
        const char* nA = has_next ? (const char*)g.A + (size_t)nxt.pm * tstep : cA; const char* nB = has_next ? (const char*)g.Bt + (size_t)nxt.pn * tstep : cB;
        for (int t = 0; t < nt; t += 2) {
            const bool last = (t == nt - 2);
            const char* a1 = cA + (size_t)(t + 1) * kstep;
            const char* a2 = last ? nA : cA + (size_t)(t + 2) * kstep; const char* b2 = last ? nB : cB + (size_t)(t + 2) * kstep;
            const char* a3 = a2 + kstep; const char* b3 = b2 + kstep;
            if (last && has_next) S.a_ready(nxt);
            if constexpr (Side::ON) { PG8_SIDE_FILL(0, sd_a); PG8_SCHED; }
            PG8_LDB(B0, 0, 0); PG8_SCHED; PG8_LDA(At, 0, 0); PG8_STAGE(PG8_SA(1, 1), a1 + hstep, voffA);
            PG8_WAIT_L(8); PG8_BAR; PG8_WAIT_L(0);
            PG8_MMA(0, 0, At, B0); PG8_BAR; PG8_SCHED;
            PG8_LDB(B1, 0, 1); PG8_STAGE(PG8_SB(0, 0), b2, voffB);
            PG8_BAR; PG8_WAIT_L(0); PG8_MMA(0, 1, At, B1); PG8_BAR;
            PG8_LDA(At, 0, 1); PG8_STAGE(PG8_SA(0, 0), a2, voffA);
            PG8_BAR; PG8_WAIT_L(0); PG8_MMA(1, 0, At, B0); PG8_BAR; PG8_SCHED;
            PG8_STAGE(PG8_SB(0, 1), b2 + hstep, voffB);
            PG8_WAIT_V(6); PG8_BAR; PG8_MMA(1, 1, At, B1); PG8_BAR;
            if constexpr (Side::ON) { PG8_SIDE_READ(0, sd_a); PG8_SCHED; }
            PG8_LDB(B0, 1, 0); PG8_SCHED; PG8_LDA(At, 1, 0); PG8_STAGE(PG8_SA(0, 1), a2 + hstep, voffA);
            PG8_WAIT_L(8); PG8_BAR; PG8_WAIT_L(0);
            if constexpr (Side::ON) { PG8_SIDE_STORE(sd_a); PG8_SCHED; }
            PG8_MMA(0, 0, At, B0); PG8_BAR; PG8_SCHED;
            PG8_LDB(B1, 1, 1); PG8_STAGE(PG8_SB(1, 0), b3, voffB);
            PG8_BAR; PG8_WAIT_L(0); PG8_MMA(0, 1, At, B1); PG8_BAR;
            PG8_LDA(At, 1, 1); PG8_STAGE(PG8_SA(1, 0), a3, voffA);
            PG8_BAR; PG8_WAIT_L(0); PG8_MMA(1, 0, At, B0); PG8_BAR; PG8_SCHED;
            PG8_STAGE(PG8_SB(1, 1), b3 + hstep, voffB);
            PG8_WAIT_V(6); PG8_BAR; PG8_MMA(1, 1, At, B1); PG8_BAR;
        }
        PG8_STAMP();
        if constexpr (!Epi::AFTER_DRAIN) { E(acc, cur, wr, wc, fr, fq); S.done(cur); }
        PG8_STAMP();
        if (!has_next) break;
#pragma unroll
        for (int a = 0; a < 2; ++a)
#pragma unroll
            for (int b = 0; b < 2; ++b)
#pragma unroll
                for (int m = 0; m < 4; ++m)
#pragma unroll
                    for (int n = 0; n < 2; ++n) acc[a][b][m][n] = (f32x4){0.f, 0.f, 0.f, 0.f};
        cur = nxt; cA = nA; cB = nB; ++ui;
    }
    PG8_WAIT_V(0);
    if (wr == 0) PG8_BAR;
    PG8_BAR;
    if constexpr (Side::ON) { while (sq_next < side.qlim) { PG8_SIDE_FILL(0, sd_a); PG8_WAIT_V(0); PG8_SIDE_READ(0, sd_a); PG8_SIDE_STORE(sd_a); } }
    if constexpr (Epi::AFTER_DRAIN) { E.fused(acc, cur, wr, wc, fr, fq, lds, wid, lane); S.done(cur); }
    PG8_STAMP();
    if (STAMP && wid == 0) { stamps[lane] = lane < nts ? (((unsigned long long)(unsigned)ts_hi << 32) | (unsigned)ts_lo) : 0ull;
        if (lane == 62) stamps[62] = rt_entry; if (lane == 63) stamps[63] = (unsigned long long)wall_clock64(); }
#undef PG8_STAMP
#undef PG8_SIDE_FILL
#undef PG8_SIDE_READ
#undef PG8_SIDE_STORE
#undef PG8_SA
#undef PG8_SB
#undef PG8_STAGE
#undef PG8_LDA
#undef PG8_LDB
#undef PG8_MMA
#undef PG8_WAIT_V
#undef PG8_WAIT_L
#undef PG8_BAR
#undef PG8_SCHED
}
}

using pg8::bf16_t; using pg8::bf16x8; using pg8::f32x4; using pg8::u32x4; using pg8::cvt_pk_bf16; using pg8::bf_lo; using pg8::bf_hi;
typedef unsigned u32x2 __attribute__((ext_vector_type(2)));
typedef float f32x2 __attribute__((ext_vector_type(2)));
#define LAS __attribute__((address_space(3)))
constexpr int NT = 512;
constexpr int DM = 2048, SEQ = 8192, NB = 2, NTOK_P = NB * SEQ, DB = 32, DS = 4, NTOK_S = DB * DS, NTOK = NTOK_P + NTOK_S, M_PAD = 16640;
constexpr int N_IN = 22528, D_ATT = 1024, HD = 128, NH = 8, PAST = 16384;
constexpr int OFF_AGATE = 9216, OFF_CONV = 10240, OFF_CGATE = 16384, OFF_MERGE = 18432;
constexpr float EPS = 1e-6f;
constexpr size_t al256(size_t x) { return (x + 255) & ~(size_t)255; }
constexpr size_t WS_XN = 0;
constexpr size_t WS_WIN = al256(WS_XN + (size_t)M_PAD * DM * 2);
constexpr size_t WS_WATT = al256(WS_WIN + (size_t)N_IN * DM * 2);
constexpr size_t WS_WCONV = al256(WS_WATT + (size_t)DM * D_ATT * 2);
constexpr size_t WS_WOUT = al256(WS_WCONV + (size_t)DM * DM * 2);
constexpr size_t WS_Z = al256(WS_WOUT + (size_t)DM * DM * 2);
constexpr size_t WS_OG = al256(WS_Z + (size_t)M_PAD * N_IN * 2);
constexpr size_t WS_LSE = al256(WS_OG + (size_t)3 * NTOK * D_ATT * 2);
constexpr size_t WS_A1 = al256(WS_LSE + (size_t)3 * NTOK * NH * 4);
constexpr size_t WS_A2 = al256(WS_A1 + (size_t)M_PAD * D_ATT * 2);
constexpr size_t WS_T = al256(WS_A2 + (size_t)M_PAD * DM * 2);
constexpr size_t WS_MB = al256(WS_T + (size_t)M_PAD * DM * 4);
constexpr size_t WS_ROPE = al256(WS_MB + (size_t)M_PAD * DM * 2);
constexpr size_t WS_CTL = al256(WS_ROPE + (size_t)(SEQ + DS) * 16 * 8);
constexpr size_t WS_END = WS_CTL + 16384;
constexpr size_t O_YP = 0, O_YS = O_YP + (size_t)NTOK_P * DM, O_KVP0 = O_YS + (size_t)NTOK_S * DM, O_KVP1 = O_KVP0 + (size_t)NB * 128 * 2048, O_KVP2 = O_KVP1 + (size_t)NB * 512 * 2048,
                 O_CVP = O_KVP2 + (size_t)NB * 2048 * 2048, O_KVS0 = O_CVP + (size_t)NB * 2 * DM, O_KVS1 = O_KVS0 + (size_t)DB * 128 * 2048, O_KVS2 = O_KVS1 + (size_t)DB * 512 * 2048,
                 O_CVS = O_KVS2 + (size_t)DB * 2048 * 2048, O_END = O_CVS + (size_t)DB * 2 * DM;
constexpr int LDS_BYTES = 147456;
constexpr int KS_STRIDE = 272;
constexpr int VT_STRIDE_DW = 130;
constexpr int VT_OFF = 256 * KS_STRIDE;
constexpr int NW_OFF = VT_OFF + 128 * VT_STRIDE_DW * 4;
static_assert(NW_OFF + 6 * 128 * 4 <= LDS_BYTES - 16, "lds");
constexpr int XB_LDS_OFF = LDS_BYTES - 16;

struct Params {
    const float* x_prompt; const float* x_sample; const float* cache[3]; const float* state_conv; const float* norm_w; const float* w_in; const float* q_norm_w; const float* k_norm_w;
    const float* conv_w; const float* w_att; const float* w_conv; const float* w_out; float* out; unsigned char* ws;
};

typedef const __attribute__((address_space(4))) Params* KP;
__device__ __constant__ float c_rope_inv[16] = {1.000000000e+00f, 4.403665960e-01f, 1.939227432e-01f, 8.539710194e-02f, 3.760603070e-02f, 1.656043902e-02f, 7.292664610e-03f, 3.211445874e-03f,
    1.414213562e-03f, 6.227723788e-04f, 2.742481884e-04f, 1.207697351e-04f, 5.318296098e-05f, 2.341999971e-05f, 1.031338616e-05f, 4.541670478e-06f};

constexpr float kRopeInv[16] = {1.000000000e+00f, 4.403665960e-01f, 1.939227432e-01f, 8.539710194e-02f, 3.760603070e-02f, 1.656043902e-02f, 7.292664610e-03f, 3.211445874e-03f,
    1.414213562e-03f, 6.227723788e-04f, 2.742481884e-04f, 1.207697351e-04f, 5.318296098e-05f, 2.341999971e-05f, 1.031338616e-05f, 4.541670478e-06f};
__device__ __forceinline__ f32x2 rope_cs(float pos, float inv) {
    const float rev = (pos * inv) * 0.15915494309189535f, fr = rev - rintf(rev);
    return (f32x2){__builtin_amdgcn_cosf(fr), __builtin_amdgcn_sinf(fr)};
}
__device__ __forceinline__ float wave_sum(float v) {
#pragma unroll
    for (int o = 32; o >= 1; o >>= 1) v += __shfl_xor(v, o);
    return v;
}
__device__ __forceinline__ float siluf(float x) { return x / (1.0f + __expf(-x)); }

__device__ __forceinline__ void p0_rmsnorm(KP p, int G, int wave, int lane) {
    bf16_t* XN = (bf16_t*)(p->ws + WS_XN);
    for (int row = blockIdx.x * 8 + wave; row < M_PAD; row += G * 8) {
        bf16_t* dst = XN + (size_t)row * DM;
        if (row >= NTOK) {
#pragma unroll
            for (int i = 0; i < 8; ++i) *(u32x2*)(dst + (i * 64 + lane) * 4) = (u32x2){0u, 0u};
            continue;
        }
        const float* src = row < NTOK_P ? p->x_prompt + (size_t)row * DM : p->x_sample + (size_t)(row - NTOK_P) * DM;
        f32x4 v[8]; float ss = 0.f;
#pragma unroll
        for (int i = 0; i < 8; ++i) { v[i] = *(const f32x4*)(src + (i * 64 + lane) * 4); ss += v[i][0] * v[i][0] + v[i][1] * v[i][1] + v[i][2] * v[i][2] + v[i][3] * v[i][3]; }
        ss = wave_sum(ss);
        const float rstd = rsqrtf(ss * (1.0f / DM) + EPS);
#pragma unroll
        for (int i = 0; i < 8; ++i) { const f32x4 w = *(const f32x4*)(p->norm_w + (i * 64 + lane) * 4);
            u32x2 o; o.x = cvt_pk_bf16(v[i][0] * rstd * w[0], v[i][1] * rstd * w[1]); o.y = cvt_pk_bf16(v[i][2] * rstd * w[2], v[i][3] * rstd * w[3]);
            *(u32x2*)(dst + (i * 64 + lane) * 4) = o; }
    }
}
__device__ __forceinline__ void p0_transpose(const float* W, bf16_t* Wt, int K, int N, LAS float* tile, int G, int tid) {
    const int tk = K / 64, tn = N / 64, ntile = tk * tn;
    for (int t = blockIdx.x; t < ntile; t += G) {
        const int k0 = (t % tk) * 64, n0 = (t / tk) * 64;
#pragma unroll
        for (int i = 0; i < 2; ++i) { const int k = (tid >> 4) + 32 * i, n4 = (tid & 15) * 4;
            const f32x4 v = *(const f32x4*)(W + (size_t)(k0 + k) * N + n0 + n4);
            tile[k * 65 + n4 + 0] = v[0]; tile[k * 65 + n4 + 1] = v[1]; tile[k * 65 + n4 + 2] = v[2]; tile[k * 65 + n4 + 3] = v[3]; }
        __syncthreads();
        { const int n = tid >> 3, k8 = (tid & 7) * 8; float f[8];
#pragma unroll
          for (int j = 0; j < 8; ++j) f[j] = tile[(k8 + j) * 65 + n];
          u32x4 o; o.x = cvt_pk_bf16(f[0], f[1]); o.y = cvt_pk_bf16(f[2], f[3]); o.z = cvt_pk_bf16(f[4], f[5]); o.w = cvt_pk_bf16(f[6], f[7]);
          *(u32x4*)(Wt + (size_t)(n0 + n) * K + k0 + k8) = o; }
        __syncthreads();
    }
}
__device__ __forceinline__ void p0_rope(KP p, int G, int tid) {
    f32x2* R = (f32x2*)(p->ws + WS_ROPE);
    for (int i = blockIdx.x * NT + tid; i < (SEQ + DS) * 16; i += G * NT) {
        const int pi = i >> 4, f = i & 15; const float pos = (float)(pi < SEQ ? pi : PAST + (pi - SEQ));
        const float ang = pos * c_rope_inv[f];
        const double t = (double)ang * 0.15915494309189533577; const float fr = (float)(t - rint(t));
        R[i] = (f32x2){__builtin_amdgcn_cosf(fr), __builtin_amdgcn_sinf(fr)};
    }
}

__device__ __forceinline__ void attn_ld_kv(const bf16_t* Z, int b, int colK, int colV, int dsh, int r, int blk, int tid, int wave, int lane, u32x4 (&kraw)[4], u32x4 (&vraw)[2][2]) {
    { const int s = ((blk * 128 + (tid >> 2)) << dsh) + r; const u32x4* src = (const u32x4*)(Z + (size_t)(b * SEQ + s) * N_IN + colK + (tid & 3) * 32);
#pragma unroll
      for (int i = 0; i < 4; ++i) kraw[i] = src[i]; }
    const int dc = (lane & 3) + 4 * (wave & 3);
#pragma unroll
    for (int ps = 0; ps < 2; ++ps) { const int kp = ps * 32 + (wave >> 2) * 16 + (lane >> 2), s0 = ((blk * 128 + 2 * kp) << dsh) + r, s1 = ((blk * 128 + 2 * kp + 1) << dsh) + r;
        vraw[ps][0] = *(const u32x4*)(Z + (size_t)(b * SEQ + s0) * N_IN + colV + dc * 8); vraw[ps][1] = *(const u32x4*)(Z + (size_t)(b * SEQ + s1) * N_IN + colV + dc * 8); }
}
__device__ __forceinline__ void attn_st_kv(KP p, LAS unsigned char* lds, int slot, bool zero, bool last, float* okv, int g, int b, int h, int W, int dsh, int r, int blk, int tid, int wave, int lane,
                                           const u32x4 (&kraw)[4], const u32x4 (&vraw)[2][2]) {
    const f32x2* ROPE = (const f32x2*)(p->ws + WS_ROPE);
    { const int row = tid >> 2, c = tid & 3, s = ((blk * 128 + row) << dsh) + r;
      float x[32];
#pragma unroll
      for (int i = 0; i < 4; ++i) { u32x4 v = kraw[i]; if (zero) v = (u32x4){0u, 0u, 0u, 0u};
          x[i * 8 + 0] = bf_lo(v.x); x[i * 8 + 1] = bf_hi(v.x); x[i * 8 + 2] = bf_lo(v.y); x[i * 8 + 3] = bf_hi(v.y); x[i * 8 + 4] = bf_lo(v.z); x[i * 8 + 5] = bf_hi(v.z); x[i * 8 + 6] = bf_lo(v.w); x[i * 8 + 7] = bf_hi(v.w); }
      float ss = 0.f;
#pragma unroll
      for (int j = 0; j < 32; ++j) ss += x[j] * x[j];
      ss += __shfl_xor(ss, 1); ss += __shfl_xor(ss, 2);
      const float rstd = rsqrtf(ss * (1.0f / HD) + EPS);
      const LAS float* kw = (const LAS float*)(lds + NW_OFF) + g * HD + c * 32;
#pragma unroll
      for (int j = 0; j < 32; ++j) x[j] = x[j] * rstd * kw[j];
      if (c == 0 && !zero) {
#pragma unroll
          for (int i = 0; i < 16; ++i) { const f32x2 cs = rope_cs((float)s, kRopeInv[i]); const float a = x[i], bb = x[i + 16]; x[i] = a * cs.x - bb * cs.y; x[i + 16] = bb * cs.x + a * cs.y; }
      }
      LAS u32x4* kd = (LAS u32x4*)(lds + (slot * 128 + row) * KS_STRIDE + c * 64);
#pragma unroll
      for (int i = 0; i < 4; ++i) { u32x4 o; o.x = cvt_pk_bf16(x[i * 8 + 0], x[i * 8 + 1]); o.y = cvt_pk_bf16(x[i * 8 + 2], x[i * 8 + 3]); o.z = cvt_pk_bf16(x[i * 8 + 4], x[i * 8 + 5]); o.w = cvt_pk_bf16(x[i * 8 + 6], x[i * 8 + 7]); kd[i] = o; }
      if (last) {
          float* d = okv + ((size_t)((b * W + (s - (SEQ - W))) * 2 + 0) * NH + h) * HD + c * 32;
#pragma unroll
          for (int i = 0; i < 8; ++i) *(f32x4*)(d + i * 4) = (f32x4){x[i * 4], x[i * 4 + 1], x[i * 4 + 2], x[i * 4 + 3]};
      }
    }
    __builtin_amdgcn_sched_barrier(0);
    LAS unsigned* vt = (LAS unsigned*)(lds + VT_OFF);
    const int dc = (lane & 3) + 4 * (wave & 3);
#pragma unroll
    for (int ps = 0; ps < 2; ++ps) { const int kp = ps * 32 + (wave >> 2) * 16 + (lane >> 2);
        u32x4 v0 = vraw[ps][0], v1 = vraw[ps][1];
        if (zero) { v0 = (u32x4){0u, 0u, 0u, 0u}; v1 = v0; }
        LAS unsigned* d = vt + (dc * 8) * VT_STRIDE_DW + slot * 64 + kp;
        d[0 * VT_STRIDE_DW] = (v0.x & 0xffffu) | (v1.x << 16); d[1 * VT_STRIDE_DW] = (v0.x >> 16) | (v1.x & 0xffff0000u);
        d[2 * VT_STRIDE_DW] = (v0.y & 0xffffu) | (v1.y << 16); d[3 * VT_STRIDE_DW] = (v0.y >> 16) | (v1.y & 0xffff0000u);
        d[4 * VT_STRIDE_DW] = (v0.z & 0xffffu) | (v1.z << 16); d[5 * VT_STRIDE_DW] = (v0.z >> 16) | (v1.z & 0xffff0000u);
        d[6 * VT_STRIDE_DW] = (v0.w & 0xffffu) | (v1.w << 16); d[7 * VT_STRIDE_DW] = (v0.w >> 16) | (v1.w & 0xffff0000u);
        if (last) {
            const int s0 = ((blk * 128 + 2 * kp) << dsh) + r, s1 = ((blk * 128 + 2 * kp + 1) << dsh) + r;
            float* d0 = okv + ((size_t)((b * W + (s0 - (SEQ - W))) * 2 + 1) * NH + h) * HD + dc * 8;
            float* d1 = okv + ((size_t)((b * W + (s1 - (SEQ - W))) * 2 + 1) * NH + h) * HD + dc * 8;
            *(f32x4*)d0 = (f32x4){bf_lo(v0.x), bf_hi(v0.x), bf_lo(v0.y), bf_hi(v0.y)}; *(f32x4*)(d0 + 4) = (f32x4){bf_lo(v0.z), bf_hi(v0.z), bf_lo(v0.w), bf_hi(v0.w)};
            *(f32x4*)d1 = (f32x4){bf_lo(v1.x), bf_hi(v1.x), bf_lo(v1.y), bf_hi(v1.y)}; *(f32x4*)(d1 + 4) = (f32x4){bf_lo(v1.z), bf_hi(v1.z), bf_lo(v1.w), bf_hi(v1.w)};
        }
    }
}
__device__ __forceinline__ void attn_prompt_chunk(KP p, LAS unsigned char* lds, int g, int b, int r, int h, int qb0, int nblk, int tid, int wave, int lane) {
    const bf16_t* Z = (const bf16_t*)(p->ws + WS_Z);
    const f32x2* ROPE = (const f32x2*)(p->ws + WS_ROPE);
    const int dsh = 2 * g, nb = 64 >> dsh;
    const int W = 128 << dsh;
    const int colQ = ((g * 3 + 0) * NH + h) * HD, colK = ((g * 3 + 1) * NH + h) * HD, colV = ((g * 3 + 2) * NH + h) * HD;
    float* okv = p->out + (g == 0 ? O_KVP0 : (g == 1 ? O_KVP1 : O_KVP2));
    const int fr = lane & 15, fq = lane >> 4;
    LAS unsigned* vt = (LAS unsigned*)(lds + VT_OFF);
    u32x4 kraw[4], vraw[2][2], qraw[4];
#pragma unroll
    for (int i = 0; i < 4; ++i) kraw[i] = (u32x4){0u, 0u, 0u, 0u};
    vraw[0][0] = vraw[0][1] = vraw[1][0] = vraw[1][1] = (u32x4){0u, 0u, 0u, 0u};
    if (qb0 > 0) attn_ld_kv(Z, b, colK, colV, dsh, r, qb0 - 1, tid, wave, lane, kraw, vraw);
    attn_st_kv(p, lds, 0, qb0 == 0, false, okv, g, b, h, W, dsh, r, qb0 > 0 ? qb0 - 1 : 0, tid, wave, lane, kraw, vraw);
    attn_ld_kv(Z, b, colK, colV, dsh, r, qb0, tid, wave, lane, kraw, vraw);
#pragma unroll 1
    for (int n = 0; n < nblk; ++n) {
        const int qb = qb0 + n, ps = n & 1, cs = ps ^ 1, kbase = qb * 128 - 128;
        const int qi = wave * 16 + fr, sq = ((qb * 128 + qi) << dsh) + r;
        const size_t tokq = (size_t)b * SEQ + sq;
#pragma unroll
        for (int ks = 0; ks < 4; ++ks) qraw[ks] = *(const u32x4*)(Z + tokq * N_IN + colQ + fq * 8 + ks * 32);
        attn_st_kv(p, lds, cs, false, qb == nb - 1, okv, g, b, h, W, dsh, r, qb, tid, wave, lane, kraw, vraw);
        __builtin_amdgcn_sched_barrier(0);
        bf16x8 qf[4];
        { float f[4][8]; float ss = 0.f;
#pragma unroll
          for (int ks = 0; ks < 4; ++ks) { const u32x4 v = qraw[ks];
              f[ks][0] = bf_lo(v.x); f[ks][1] = bf_hi(v.x); f[ks][2] = bf_lo(v.y); f[ks][3] = bf_hi(v.y); f[ks][4] = bf_lo(v.z); f[ks][5] = bf_hi(v.z); f[ks][6] = bf_lo(v.w); f[ks][7] = bf_hi(v.w);
#pragma unroll
              for (int j = 0; j < 8; ++j) ss += f[ks][j] * f[ks][j]; }
          ss += __shfl_xor(ss, 16); ss += __shfl_xor(ss, 32);
          const float rstd = rsqrtf(ss * (1.0f / HD) + EPS);
          const LAS float* qw = (const LAS float*)(lds + NW_OFF) + 3 * HD + g * HD + fq * 8;
#pragma unroll
          for (int ks = 0; ks < 4; ++ks)
#pragma unroll
              for (int j = 0; j < 8; ++j) f[ks][j] = f[ks][j] * rstd * qw[ks * 32 + j];
#pragma unroll
          for (int j = 0; j < 8; ++j) { const float own = f[0][j], oth = __shfl_xor(own, 32); const f32x2 csn = rope_cs((float)sq, (fq & 1) ? kRopeInv[8 + j] : kRopeInv[j]);
              f[0][j] = (fq < 2) ? own * csn.x - oth * csn.y : own * csn.x + oth * csn.y; }
          const float sc = 0.08838834764831845f * 1.4426950408889634f;
#pragma unroll
          for (int ks = 0; ks < 4; ++ks) { u32x4 o; o.x = cvt_pk_bf16(f[ks][0] * sc, f[ks][1] * sc); o.y = cvt_pk_bf16(f[ks][2] * sc, f[ks][3] * sc); o.z = cvt_pk_bf16(f[ks][4] * sc, f[ks][5] * sc); o.w = cvt_pk_bf16(f[ks][6] * sc, f[ks][7] * sc);
              qf[ks] = __builtin_bit_cast(bf16x8, o); }
        }
        __builtin_amdgcn_sched_barrier(0);
        if (n < nblk - 1) {
            attn_ld_kv(Z, b, colK, colV, dsh, r, qb + 1, tid, wave, lane, kraw, vraw);
        }
        __builtin_amdgcn_sched_barrier(0);
        __syncthreads();
        f32x4 sacc[9];
        __builtin_amdgcn_s_setprio(1);
#pragma unroll
        for (int kt = 0; kt < 9; ++kt) { sacc[kt] = (f32x4){0.f, 0.f, 0.f, 0.f};
            const int T = wave + kt, lrow = ((T < 8 ? ps : cs) * 128) + (T & 7) * 16 + fr;
            const LAS unsigned char* kr = lds + lrow * KS_STRIDE + fq * 16;
#pragma unroll
            for (int ks = 0; ks < 4; ++ks) { const bf16x8 a = *(const LAS bf16x8*)(kr + ks * 64); sacc[kt] = __builtin_amdgcn_mfma_f32_16x16x32_bf16(a, qf[ks], sacc[kt], 0, 0, 0); }
            if ((kt % 3) == 2) __builtin_amdgcn_sched_barrier(0);
        }
        __builtin_amdgcn_s_setprio(0);
        float mx = -3.0e38f;
#pragma unroll
        for (int kt = 0; kt < 9; ++kt)
#pragma unroll
            for (int e = 0; e < 4; ++e) { const int kj = (wave + kt) * 16 + fq * 4 + e; const bool ok = (kj >= qi) && (kj <= qi + 128) && (kbase + kj >= 0);
                sacc[kt][e] = ok ? sacc[kt][e] : -3.0e38f; mx = fmaxf(mx, sacc[kt][e]); }
        mx = fmaxf(mx, __shfl_xor(mx, 16)); mx = fmaxf(mx, __shfl_xor(mx, 32));
        float sum = 0.f;
#pragma unroll
        for (int kt = 0; kt < 9; ++kt)
#pragma unroll
            for (int e = 0; e < 4; ++e) { const float pe = __builtin_amdgcn_exp2f(sacc[kt][e] - mx); sacc[kt][e] = pe; sum += pe; }
        sum += __shfl_xor(sum, 16); sum += __shfl_xor(sum, 32);
        const float inv = 1.0f / sum;
        if (fq == 0) ((float*)(p->ws + WS_LSE))[((size_t)g * NTOK + tokq) * NH + h] = (mx + __builtin_amdgcn_logf(sum)) * 0.6931471805599453f;
        bf16x8 pf[5];
#pragma unroll
        for (int kk = 0; kk < 5; ++kk) { u32x4 o; o.x = cvt_pk_bf16(sacc[2 * kk][0] * inv, sacc[2 * kk][1] * inv); o.y = cvt_pk_bf16(sacc[2 * kk][2] * inv, sacc[2 * kk][3] * inv);
            if (kk < 4) { o.z = cvt_pk_bf16(sacc[2 * kk + 1][0] * inv, sacc[2 * kk + 1][1] * inv); o.w = cvt_pk_bf16(sacc[2 * kk + 1][2] * inv, sacc[2 * kk + 1][3] * inv); } else { o.z = 0u; o.w = 0u; }
            pf[kk] = __builtin_bit_cast(bf16x8, o); }
        bf16_t* og = (bf16_t*)(p->ws + WS_OG) + ((size_t)g * NTOK + tokq) * D_ATT + h * HD + fq * 4;
        int vcol[5][2];
#pragma unroll
        for (int kk = 0; kk < 5; ++kk) { const int T0 = wave + 2 * kk, T1 = T0 + 1;
            vcol[kk][0] = (T0 < 8 ? ps : cs) * 64 + (T0 & 7) * 8 + fq * 2; vcol[kk][1] = (T1 < 8 ? ps : cs) * 64 + (T1 & 7) * 8 + fq * 2; }
#pragma unroll 2
        for (int dt = 0; dt < 8; ++dt) { f32x4 oacc = (f32x4){0.f, 0.f, 0.f, 0.f};
            const LAS unsigned* vr = vt + (dt * 16 + fr) * VT_STRIDE_DW;
#pragma unroll
            for (int kk = 0; kk < 5; ++kk) { u32x4 a; const u32x2 lo = *(const LAS u32x2*)(vr + vcol[kk][0]); a.x = lo.x; a.y = lo.y;
                if (kk < 4) { const u32x2 hi = *(const LAS u32x2*)(vr + vcol[kk][1]); a.z = hi.x; a.w = hi.y; } else { a.z = 0u; a.w = 0u; }
                oacc = __builtin_amdgcn_mfma_f32_16x16x32_bf16(__builtin_bit_cast(bf16x8, a), pf[kk], oacc, 0, 0, 0); }
            u32x2 o; o.x = cvt_pk_bf16(oacc[0], oacc[1]); o.y = cvt_pk_bf16(oacc[2], oacc[3]);
            *(u32x2*)(og + dt * 16) = o; }
        __syncthreads();
    }
}
__device__ __forceinline__ void attn_sample_item(KP p, LAS unsigned char* lds, int item, int tid, int wave, int lane) {
    const bf16_t* Z = (const bf16_t*)(p->ws + WS_Z);
    const f32x2* ROPE = (const f32x2*)(p->ws + WS_ROPE);
    const int h = item & 7, g = (item >> 3) % 3, b = item / 24;
    const int dsh = 2 * g, W = 128 << dsh, dil = 1 << dsh;
    const float* cache = p->cache[g] + (size_t)b * W * 2048;
    float* okv = p->out + (g == 0 ? O_KVS0 : (g == 1 ? O_KVS1 : O_KVS2)) + (size_t)b * W * 2048;
    LAS float* qn = (LAS float*)lds;
    LAS float* kn = qn + 512;
    LAS float* vn = kn + 512;
    LAS float* sc = vn + 512;
    { const int t = wave >> 1, kind = wave & 1; const size_t row = (size_t)NTOK_P + b * DS + t;
      const int col = ((g * 3 + kind) * NH + h) * HD + 2 * lane;
      const unsigned u = *(const unsigned*)(Z + row * N_IN + col);
      float x0 = bf_lo(u), x1 = bf_hi(u);
      const float ss = wave_sum(x0 * x0 + x1 * x1);
      const float rstd = rsqrtf(ss * (1.0f / HD) + EPS);
      const float* nw = (kind == 0 ? p->q_norm_w : p->k_norm_w) + g * HD + 2 * lane;
      x0 = x0 * rstd * nw[0]; x1 = x1 * rstd * nw[1];
      const float o0 = __shfl_xor(x0, 8), o1 = __shfl_xor(x1, 8);
      if (lane < 16) { const int i0 = 2 * (lane & 7); const f32x2 c0 = ROPE[(SEQ + t) * 16 + i0], c1 = ROPE[(SEQ + t) * 16 + i0 + 1];
          if (lane < 8) { x0 = x0 * c0.x - o0 * c0.y; x1 = x1 * c1.x - o1 * c1.y; } else { x0 = x0 * c0.x + o0 * c0.y; x1 = x1 * c1.x + o1 * c1.y; } }
      if (kind == 0) { qn[t * 128 + 2 * lane] = x0 * 0.08838834764831845f; qn[t * 128 + 2 * lane + 1] = x1 * 0.08838834764831845f; }
      else { kn[t * 128 + 2 * lane] = x0; kn[t * 128 + 2 * lane + 1] = x1;
          const unsigned uv = *(const unsigned*)(Z + row * N_IN + ((g * 3 + 2) * NH + h) * HD + 2 * lane);
          const float v0 = bf_lo(uv), v1 = bf_hi(uv);
          vn[t * 128 + 2 * lane] = v0; vn[t * 128 + 2 * lane + 1] = v1;
          float* dk = okv + ((size_t)((W - DS + t) * 2 + 0) * NH + h) * HD + 2 * lane; float* dv = okv + ((size_t)((W - DS + t) * 2 + 1) * NH + h) * HD + 2 * lane;
          *(f32x2*)dk = (f32x2){x0, x1}; *(f32x2*)dv = (f32x2){v0, v1}; }
    }
    __syncthreads();
    const int lg = tid >> 4, l16 = tid & 15, t = lg >> 3, sub = lg & 7;
    f32x4 q0, q1; { const LAS float* qp = qn + t * 128 + l16 * 8; q0 = *(const LAS f32x4*)qp; q1 = *(const LAS f32x4*)(qp + 4); }
    float m_run = -3.0e38f, l_run = 0.f; f32x4 o0 = (f32x4){0.f, 0.f, 0.f, 0.f}, o1 = o0;
#pragma unroll
    for (int chunk = 0; chunk < 2; ++chunk) {
        constexpr int NS0 = 9; const int sbase = chunk * NS0;
        f32x4 kr[NS0][2], vr[NS0][2];
#pragma unroll
        for (int i = 0; i < NS0; ++i) { const int j = sub + 8 * (sbase + i);
            if (chunk == 1 && i == NS0 - 1) { kr[i][0] = kr[i][1] = vr[i][0] = vr[i][1] = (f32x4){0.f, 0.f, 0.f, 0.f}; continue; }
            int idx = W + t - j * dil; idx = (j <= 128 && idx >= 0) ? idx : 0;
            if (idx >= W) { const LAS float* kp = kn + (idx - W) * 128 + l16 * 8; const LAS float* vp = vn + (idx - W) * 128 + l16 * 8;
                kr[i][0] = *(const LAS f32x4*)kp; kr[i][1] = *(const LAS f32x4*)(kp + 4); vr[i][0] = *(const LAS f32x4*)vp; vr[i][1] = *(const LAS f32x4*)(vp + 4); }
            else { const float* kp = cache + ((size_t)(idx * 2 + 0) * NH + h) * HD + l16 * 8; const float* vp = kp + NH * HD;
                kr[i][0] = *(const f32x4*)kp; kr[i][1] = *(const f32x4*)(kp + 4); vr[i][0] = *(const f32x4*)vp; vr[i][1] = *(const f32x4*)(vp + 4); } }
#pragma unroll
        for (int i = 0; i < NS0; ++i) { const int j = sub + 8 * (sbase + i);
            if (chunk == 1 && i == NS0 - 1) continue;
            const bool valid = (j <= 128) && (W + t - j * dil >= 0);
            float d = kr[i][0][0] * q0[0] + kr[i][0][1] * q0[1] + kr[i][0][2] * q0[2] + kr[i][0][3] * q0[3] + kr[i][1][0] * q1[0] + kr[i][1][1] * q1[1] + kr[i][1][2] * q1[2] + kr[i][1][3] * q1[3];
            d += __shfl_xor(d, 1); d += __shfl_xor(d, 2); d += __shfl_xor(d, 4); d += __shfl_xor(d, 8);
            if (valid) { const float mn = fmaxf(m_run, d), corr = __expf(m_run - mn), pe = __expf(d - mn);
                l_run = l_run * corr + pe; o0 = o0 * corr + vr[i][0] * pe; o1 = o1 * corr + vr[i][1] * pe; m_run = mn; } }
    }
    LAS float* po = (LAS float*)(lds + 8192);
    LAS float* pm = po + 32 * 128;
    *(LAS f32x4*)(po + lg * 128 + l16 * 8) = o0; *(LAS f32x4*)(po + lg * 128 + l16 * 8 + 4) = o1;
    if (l16 == 0) { pm[lg] = m_run; pm[32 + lg] = l_run; }
    __syncthreads();
    { const int tt = tid >> 7, d = tid & 127; float M = -3.0e38f;
#pragma unroll
      for (int u = 0; u < 8; ++u) M = fmaxf(M, pm[tt * 8 + u]);
      float L = 0.f, O = 0.f;
#pragma unroll
      for (int u = 0; u < 8; ++u) { const float w = __expf(pm[tt * 8 + u] - M); L += pm[32 + tt * 8 + u] * w; O += po[(tt * 8 + u) * 128 + d] * w; }
      O /= L;
      bf16_t* og = (bf16_t*)(p->ws + WS_OG) + ((size_t)g * NTOK + NTOK_P + b * DS + tt) * D_ATT + h * HD + d;
      const float on = __shfl_down(O, 1);
      if ((lane & 1) == 0) *(unsigned*)og = cvt_pk_bf16(O, on);
      if (d == 0) ((float*)(p->ws + WS_LSE))[((size_t)g * NTOK + NTOK_P + b * DS + tt) * NH + h] = M + __logf(L);
    }
    __syncthreads();
}

__device__ __forceinline__ void unpack8(const u32x4 v, float (&f)[8]) { f[0] = bf_lo(v.x); f[1] = bf_hi(v.x); f[2] = bf_lo(v.y); f[3] = bf_hi(v.y); f[4] = bf_lo(v.z); f[5] = bf_hi(v.z); f[6] = bf_lo(v.w); f[7] = bf_hi(v.w); }
__device__ __forceinline__ u32x4 pack8(const float (&f)[8]) { u32x4 o; o.x = cvt_pk_bf16(f[0], f[1]); o.y = cvt_pk_bf16(f[2], f[3]); o.z = cvt_pk_bf16(f[4], f[5]); o.w = cvt_pk_bf16(f[6], f[7]); return o; }
template <bool DO_A1, bool DO_A2> __device__ __forceinline__ void p3_rows(KP p, int G, int wave, int lane, int pass_lo, int pass_hi) {
    const bf16_t* Z = (const bf16_t*)(p->ws + WS_Z);
    const bf16_t* OG = (const bf16_t*)(p->ws + WS_OG);
    const float* LSE = (const float*)(p->ws + WS_LSE);
    bf16_t* A1 = (bf16_t*)(p->ws + WS_A1); bf16_t* A2 = (bf16_t*)(p->ws + WS_A2);
    for (int pass = pass_lo; pass < pass_hi; ++pass) { const int row = blockIdx.x * 8 + wave + pass * G * 8; if (row >= M_PAD) break;
        if (row >= NTOK) {
            if (DO_A1) {
#pragma unroll
            for (int i = 0; i < 2; ++i) *(u32x4*)(A1 + (size_t)row * D_ATT + (lane + 64 * i) * 8) = (u32x4){0u, 0u, 0u, 0u}; }
            if (DO_A2) {
#pragma unroll
            for (int i = 0; i < 4; ++i) *(u32x4*)(A2 + (size_t)row * DM + (lane + 64 * i) * 8) = (u32x4){0u, 0u, 0u, 0u}; }
            continue;
        }
        const bf16_t* zr = Z + (size_t)row * N_IN;
        if (DO_A1)
#pragma unroll
        for (int i = 0; i < 2; ++i) { const int ch = lane + 64 * i, col = ch * 8, h = ch >> 4;
            const float l0 = LSE[((size_t)0 * NTOK + row) * NH + h], l1 = LSE[((size_t)1 * NTOK + row) * NH + h], l2 = LSE[((size_t)2 * NTOK + row) * NH + h];
            const float mx = fmaxf(l0, fmaxf(l1, l2)); float w0 = __expf(l0 - mx), w1 = __expf(l1 - mx), w2 = __expf(l2 - mx); const float inv = 1.0f / (w0 + w1 + w2); w0 *= inv; w1 *= inv; w2 *= inv;
            float o0[8], o1[8], o2[8], ga[8], r[8];
            unpack8(*(const u32x4*)(OG + ((size_t)0 * NTOK + row) * D_ATT + col), o0); unpack8(*(const u32x4*)(OG + ((size_t)1 * NTOK + row) * D_ATT + col), o1);
            unpack8(*(const u32x4*)(OG + ((size_t)2 * NTOK + row) * D_ATT + col), o2); unpack8(*(const u32x4*)(zr + OFF_AGATE + col), ga);
#pragma unroll
            for (int j = 0; j < 8; ++j) r[j] = (w0 * o0[j] + w1 * o1[j] + w2 * o2[j]) * siluf(ga[j]);
            *(u32x4*)(A1 + (size_t)row * D_ATT + col) = pack8(r); }
        const bool samp = row >= NTOK_P; const int pos = samp ? ((row - NTOK_P) & (DS - 1)) : (row & (SEQ - 1)); const int bs = samp ? (row - NTOK_P) >> 2 : row >> 13;
        if (DO_A2)
#pragma unroll
        for (int i = 0; i < 4; ++i) { const int col = (lane + 64 * i) * 8;
            float hh[8], cc[8], bb[8], gg[8], u0[8], u1[8], u2[8], r[8];
            unpack8(*(const u32x4*)(zr + OFF_CONV + col), hh); unpack8(*(const u32x4*)(zr + OFF_CONV + 2 * DM + col), cc);
            unpack8(*(const u32x4*)(zr + OFF_CONV + DM + col), bb); unpack8(*(const u32x4*)(zr + OFF_CGATE + col), gg);
#pragma unroll
            for (int j = 0; j < 8; ++j) u0[j] = cc[j] * hh[j];
#pragma unroll
            for (int k = 1; k <= 2; ++k) { float (&uk)[8] = (k == 1) ? u1 : u2;
                if (pos - k >= 0) { float h2[8], c2[8]; unpack8(*(const u32x4*)(zr - (size_t)k * N_IN + OFF_CONV + col), h2); unpack8(*(const u32x4*)(zr - (size_t)k * N_IN + OFF_CONV + 2 * DM + col), c2);
#pragma unroll
                    for (int j = 0; j < 8; ++j) uk[j] = c2[j] * h2[j]; }
                else if (samp) { const float* st = p->state_conv + ((size_t)bs * 2 + (2 + pos - k)) * DM + col; const f32x4 a = *(const f32x4*)st, b2 = *(const f32x4*)(st + 4);
                    uk[0] = a[0]; uk[1] = a[1]; uk[2] = a[2]; uk[3] = a[3]; uk[4] = b2[0]; uk[5] = b2[1]; uk[6] = b2[2]; uk[7] = b2[3]; }
                else {
#pragma unroll
                    for (int j = 0; j < 8; ++j) uk[j] = 0.f; } }
            const float* cw = p->conv_w + col;
#pragma unroll
            for (int j = 0; j < 8; ++j) r[j] = bb[j] * (cw[j] * u2[j] + cw[DM + j] * u1[j] + cw[2 * DM + j] * u0[j]) * siluf(gg[j]);
            *(u32x4*)(A2 + (size_t)row * DM + col) = pack8(r);
            if (pos >= (samp ? DS : SEQ) - 2) {
                float* d = p->out + (samp ? O_CVS : O_CVP) + ((size_t)bs * 2 + (pos - ((samp ? DS : SEQ) - 2))) * DM + col;
                *(f32x4*)d = (f32x4){u0[0], u0[1], u0[2], u0[3]}; *(f32x4*)(d + 4) = (f32x4){u0[4], u0[5], u0[6], u0[7]}; } }
    }
}

template <int K> __device__ __forceinline__ f32x4 skinny_acc(const bf16_t* A, const bf16_t* Wt, int ct, int rt, int kh, int lane, f32x4 acc) {
    const int fr = lane & 15, fq = lane >> 4;
    const bf16_t* ap = A + (size_t)(rt * 16 + fr) * K + kh * (K / 2) + fq * 8;
    const bf16_t* bp = Wt + (size_t)(ct * 16 + fr) * K + kh * (K / 2) + fq * 8;
#pragma unroll 1
    for (int k0 = 0; k0 < K / 2; k0 += 512) {
        bf16x8 a[16], b[16];
#pragma unroll
        for (int i = 0; i < 16; ++i) { a[i] = *(const bf16x8*)(ap + k0 + i * 32); b[i] = *(const bf16x8*)(bp + k0 + i * 32); }
#pragma unroll
        for (int i = 0; i < 16; ++i) acc = __builtin_amdgcn_mfma_f32_16x16x32_bf16(a[i], b[i], acc, 0, 0, 0);
    }
    return acc;
}
__device__ __forceinline__ void p4_sample(KP p, LAS unsigned char* lds, int blk, int wave, int lane) {
    const bf16_t* Z = (const bf16_t*)(p->ws + WS_Z); bf16_t* MB = (bf16_t*)(p->ws + WS_MB);
    const int ct = blk >> 1, rt = 4 * (blk & 1) + (wave & 3), kh = wave >> 2;
    const f32x4 z4 = (f32x4){0.f, 0.f, 0.f, 0.f};
    f32x4 a = skinny_acc<D_ATT>((const bf16_t*)(p->ws + WS_A1) + (size_t)NTOK_P * D_ATT, (const bf16_t*)(p->ws + WS_WATT), ct, rt, kh, lane, z4);
    f32x4 c = skinny_acc<DM>((const bf16_t*)(p->ws + WS_A2) + (size_t)NTOK_P * DM, (const bf16_t*)(p->ws + WS_WCONV), ct, rt, kh, lane, z4);
    LAS f32x4* red = (LAS f32x4*)lds;
    if (kh == 1) { red[(wave & 3) * 64 + lane] = a; red[256 + (wave & 3) * 64 + lane] = c; }
    __syncthreads();
    if (kh == 0) { a += red[(wave & 3) * 64 + lane]; c += red[256 + (wave & 3) * 64 + lane];
        const int n = ct * 16 + (lane & 15), fq = lane >> 4;
#pragma unroll
        for (int r = 0; r < 4; ++r) { const size_t row = (size_t)NTOK_P + rt * 16 + fq * 4 + r;
            const float l1 = __uint_as_float((unsigned)Z[row * N_IN + OFF_MERGE + n] << 16), l2 = __uint_as_float((unsigned)Z[row * N_IN + OFF_MERGE + DM + n] << 16);
            MB[row * DM + n] = (bf16_t)(cvt_pk_bf16(pg8::sigm(l1) * a[r] + pg8::sigm(l2) * c[r], 0.f) & 0xffffu); } }
    __syncthreads();
}
__device__ __forceinline__ void p5_sample(KP p, LAS unsigned char* lds, int blk, int wave, int lane) {
    const int ct = blk >> 1, rt = 4 * (blk & 1) + (wave & 3), kh = wave >> 2;
    f32x4 acc = skinny_acc<DM>((const bf16_t*)(p->ws + WS_MB) + (size_t)NTOK_P * DM, (const bf16_t*)(p->ws + WS_WOUT), ct, rt, kh, lane, (f32x4){0.f, 0.f, 0.f, 0.f});
    LAS f32x4* red = (LAS f32x4*)lds;
    if (kh == 1) red[(wave & 3) * 64 + lane] = acc;
    __syncthreads();
    if (kh == 0) { acc += red[(wave & 3) * 64 + lane];
        const int n = ct * 16 + (lane & 15), fq = lane >> 4;
#pragma unroll
        for (int r = 0; r < 4; ++r) { const size_t m = (size_t)rt * 16 + fq * 4 + r; (p->out + O_YS)[m * DM + n] = p->x_sample[m * DM + n] + acc[r]; } }
    __syncthreads();
}

constexpr int COPY_R_IN = 69504;
__device__ __forceinline__ void tail_copy(const pg8::CopySide& C, int c, int n, int tid) {
#pragma unroll 1
    for (int q = COPY_R_IN + c; q < pg8::CopySide::R2; q += 8 * n) {
        f32x4 v[8];
#pragma unroll
        for (int u = 0; u < 8; ++u) { const int qq = q + u * n; if (qq < pg8::CopySide::R2) { const float* s_; float* d_; C.rows(qq, s_, d_); v[u] = __builtin_nontemporal_load((const f32x4*)s_ + tid); } }
#pragma unroll
        for (int u = 0; u < 8; ++u) { const int qq = q + u * n; if (qq < pg8::CopySide::R2) { const float* s_; float* d_; C.rows(qq, s_, d_); __builtin_nontemporal_store(v[u], (f32x4*)d_ + tid); } }
    }
}

#define XB_TMO      128
#define XB_XCNT(j)  (256  + 64 * (j))
#define XB_XSUB(j)  (1280 + 64 * (j))
#define XB_XGEN(j)  (2304 + 64 * (j))
#define XB_TOP      3328
#define XB_TOPGEN   3392
#define XCD_BAR_WORDS 3456
#define XB_SPIN_CAP (1u << 22)
__device__ __forceinline__ unsigned xb_ld(unsigned* q)              { return __hip_atomic_load(q, __ATOMIC_RELAXED, __HIP_MEMORY_SCOPE_AGENT); }
__device__ __forceinline__ unsigned xb_add(unsigned* q, unsigned v) { return __hip_atomic_fetch_add(q, v, __ATOMIC_RELAXED, __HIP_MEMORY_SCOPE_AGENT); }
__device__ __forceinline__ unsigned xb_xcc_id() { return (unsigned)__builtin_amdgcn_s_getreg((3 << 11) | 20) & 0xFu; }
#define XB_SPIN(cond, bar) do { unsigned _sp = 0; while (cond) { __builtin_amdgcn_s_sleep(1); \
    if ((++_sp & 255u) == 0u) { if (xb_ld(&(bar)[XB_TMO])) break; if (_sp > XB_SPIN_CAP) { atomicAdd(&(bar)[XB_TMO], 1u); break; } } } } while (0)
__device__ __forceinline__ void xcd_barrier_complete(unsigned* bar, unsigned x, unsigned& nloc, unsigned& nx) {
    const unsigned G = gridDim.x;
    unsigned sum, cnt, mine, sp = 0u;
    for (;;) {
        sum = 0u; cnt = 0u; mine = 0u;
#pragma unroll
        for (unsigned j = 0; j < 16; ++j) { const unsigned c = xb_ld(&bar[XB_XCNT(j)]); sum += c; cnt += (c > 0u) ? 1u : 0u; mine = (j == x) ? c : mine; }
        if (sum == G) break;
        __builtin_amdgcn_s_sleep(1);
        if ((++sp & 255u) == 0u) { if (xb_ld(&bar[XB_TMO])) break; if (sp > XB_SPIN_CAP) { atomicAdd(&bar[XB_TMO], 1u); break; } }
    }
    nloc = mine > 0u ? mine : 1u; nx = cnt > 0u ? cnt : 1u;
}
__device__ __forceinline__ void xcd_barrier(unsigned* bar, unsigned x, volatile LAS unsigned* st) {
    asm volatile("s_waitcnt vmcnt(0)" ::: "memory");
    __syncthreads();
    if (threadIdx.x == 0) {
        __builtin_amdgcn_s_waitcnt(0);
        unsigned nloc = st[0], nx = st[1];
        if (nloc == 0u) { xcd_barrier_complete(bar, x, nloc, nx); st[0] = nloc; st[1] = nx; }
        const unsigned old = xb_add(&bar[XB_XSUB(x)], 1u);
        const unsigned gen = old / nloc;
        if (old + 1u == (gen + 1u) * nloc) {
            __builtin_amdgcn_fence(__ATOMIC_RELEASE, "agent");
            asm volatile("s_waitcnt vmcnt(0)" ::: "memory");
            const unsigned og = xb_add(&bar[XB_TOP], 1u);
            const unsigned tg = og / nx;
            if (og + 1u == (tg + 1u) * nx) xb_add(&bar[XB_TOPGEN], 1u);
            else XB_SPIN(xb_ld(&bar[XB_TOPGEN]) == tg, bar);
            __builtin_amdgcn_fence(__ATOMIC_ACQUIRE, "agent");
            xb_add(&bar[XB_XGEN(x)], 1u);
            asm volatile("s_waitcnt vmcnt(0)" ::: "memory");
        } else {
            XB_SPIN(xb_ld(&bar[XB_XGEN(x)]) == gen, bar);
            __builtin_amdgcn_fence(__ATOMIC_ACQUIRE, "agent");
            asm volatile("s_waitcnt vmcnt(0)" ::: "memory");
        }
    }
    __syncthreads();
}

#ifndef N_LAUNCHES
#define N_LAUNCHES 1
#endif
#ifndef PROBE_REP_PHASE
#define PROBE_REP_PHASE -1
#endif
#define REP(k) ((k) == PROBE_REP_PHASE ? 2 : 1)
struct KArgs { Params p; int ph_lo, ph_hi, use_cg, pad; };
__global__ void __launch_bounds__(NT, 2) fwd_mega(KArgs a_unused) {
    typedef const __attribute__((address_space(4))) KArgs* KA;
    KA ka = (KA)__builtin_amdgcn_kernarg_segment_ptr();
    KP p = (KP)ka;
    const int lo = ka->ph_lo, hi = ka->ph_hi, use_cg = ka->use_cg;
#define RELOAD() asm volatile("" : "+s"(p))
#define IN(k) (lo <= (k) && (k) < hi)
#define GSYNC(k) do { if (IN(k) && IN((k) + 1)) { if (use_cg) { asm volatile("s_waitcnt vmcnt(0)" ::: "memory"); __builtin_amdgcn_fence(__ATOMIC_RELEASE, "agent"); grid.sync(); __builtin_amdgcn_fence(__ATOMIC_ACQUIRE, "agent"); } \
        else xcd_barrier((unsigned*)(p->ws + WS_CTL), xcc, (volatile LAS unsigned*)(lds + XB_LDS_OFF)); } RELOAD(); } while (0)
    extern __shared__ __attribute__((aligned(16))) unsigned char lds_raw[];
    LAS unsigned char* lds = (LAS unsigned char*)lds_raw;
    cg::grid_group grid = cg::this_grid();
    const int tid = threadIdx.x, lane = tid & 63, wave = __builtin_amdgcn_readfirstlane(tid >> 6), G = gridDim.x;
    const unsigned xcc = xb_xcc_id();
    if (N_LAUNCHES == 1) {
        if (tid < 2) ((volatile LAS unsigned*)(lds + XB_LDS_OFF))[tid] = 0u;
        __syncthreads();
        if (tid == 0) (void)xb_add((unsigned*)(p->ws + WS_CTL) + XB_XCNT(xcc), 1u);
    }
    if (IN(0)) for (int rep = 0; rep < REP(0); ++rep) {
    p0_rope(p, G, tid);
    p0_rmsnorm(p, G, wave, lane);
    p0_transpose(p->w_in, (bf16_t*)(p->ws + WS_WIN), DM, N_IN, (LAS float*)lds, G, tid);
    p0_transpose(p->w_att, (bf16_t*)(p->ws + WS_WATT), D_ATT, DM, (LAS float*)lds, G, tid);
    p0_transpose(p->w_conv, (bf16_t*)(p->ws + WS_WCONV), DM, DM, (LAS float*)lds, G, tid);
    p0_transpose(p->w_out, (bf16_t*)(p->ws + WS_WOUT), DM, DM, (LAS float*)lds, G, tid);
    }
    GSYNC(0);
    if (IN(1)) { pg8::Gemm g{(const bf16_t*)(p->ws + WS_XN), (const bf16_t*)(p->ws + WS_WIN), M_PAD, N_IN, DM}; pg8::StaticOrder S; S.init(M_PAD, N_IN, G, (int)blockIdx.x);
      pg8::EpiZ E{(bf16_t*)(p->ws + WS_Z), N_IN};
      pg8::CopySide C{p->cache[0], p->cache[1], p->cache[2], p->out + O_KVS0, p->out + O_KVS1, p->out + O_KVS2, (int)blockIdx.x, G, COPY_R_IN};
      pg8::gemm_phase<pg8::EpiZ, pg8::StaticOrder, pg8::CopySide>(lds, g, S, E, nullptr, C, pg8::STAGE_BYTES);
      { const int nlast = ((M_PAD / 256) * (N_IN / 256)) % G;
        if ((int)blockIdx.x >= nlast) tail_copy(C, (int)blockIdx.x - nlast, G - nlast, tid); } }
    GSYNC(1);
    if (IN(2)) for (int rep = 0; rep < REP(2); ++rep) {
    if (tid < 384) ((LAS float*)(lds + NW_OFF))[tid] = p->k_norm_w[tid]; else if (tid < 768 - 384 + 384 && tid - 384 < 128) ((LAS float*)(lds + NW_OFF))[384 + (tid - 384)] = p->q_norm_w[tid - 384];
    if (tid < 256) ((LAS float*)(lds + NW_OFF))[512 + tid] = p->q_norm_w[128 + tid];
    __syncthreads();
    for (int rp = 0; rp < REP(20); ++rp)
    { int a2pass = 0;
      for (int it = blockIdx.x; it < 256; it += G)
#pragma unroll 1
          for (int sub = 0; sub < 2; ++sub) {
              int cg, cb, cr, ch, cq, cn;
              if (sub == 1) { cg = 2; cb = it >> 7; cr = (it >> 3) & 15; ch = it & 7; cq = 0; cn = 4; }
              else if (it < 128) { const int st = it >> 3; cg = 0; cb = st >> 3; cr = 0; ch = st & 7; cq = (it & 7) * 8; cn = 8; }
              else { const int j = it - 128, st = j >> 1; cg = 1; cb = st >> 5; cr = (st >> 3) & 3; ch = st & 7; cq = (j & 1) * 8; cn = 8; }
              attn_prompt_chunk(p, lds, cg, cb, cr, ch, cq, cn, tid, wave, lane);
              const int np_ = sub ? 4 : 5; p3_rows<false, true>(p, G, wave, lane, a2pass, a2pass + np_); a2pass += np_; }
      p3_rows<false, true>(p, G, wave, lane, a2pass, 1 << 20); }
    for (int rp = 0; rp < REP(21); ++rp)
    for (int it = blockIdx.x; it < 768; it += G) attn_sample_item(p, lds, it, tid, wave, lane);
    }
    GSYNC(2);
    if (IN(3)) for (int rep = 0; rep < REP(3); ++rep) p3_rows<true, false>(p, G, wave, lane, 0, 1 << 20);
    GSYNC(3);
    if (IN(4)) { pg8::Gemm g{(const bf16_t*)(p->ws + WS_A1), (const bf16_t*)(p->ws + WS_WATT), NTOK_P, DM, D_ATT}; pg8::StaticOrder S; S.init(NTOK_P, DM, G, (int)blockIdx.x);
      pg8::EpiT E{(bf16_t*)(p->ws + WS_T), DM, (const bf16_t*)(p->ws + WS_Z), N_IN, OFF_MERGE};
      pg8::gemm_phase<pg8::EpiT, pg8::StaticOrder>(lds, g, S, E, nullptr); }
    if (N_LAUNCHES != 1) { GSYNC(4); } else { asm volatile("s_waitcnt vmcnt(0)" ::: "memory"); RELOAD(); }
    if (IN(5)) { pg8::Gemm g{(const bf16_t*)(p->ws + WS_A2), (const bf16_t*)(p->ws + WS_WCONV), NTOK_P, DM, DM}; pg8::StaticOrder S; S.init(NTOK_P, DM, G, (int)blockIdx.x);
      pg8::EpiM E{(const bf16_t*)(p->ws + WS_T), DM, (bf16_t*)(p->ws + WS_MB), DM, (const bf16_t*)(p->ws + WS_Z), N_IN, OFF_MERGE + DM};
      pg8::gemm_phase<pg8::EpiM, pg8::StaticOrder>(lds, g, S, E, nullptr);
      if (G == 256) p4_sample(p, lds, (int)blockIdx.x, wave, lane); else if (blockIdx.x == 0) { for (int bk = 0; bk < 256; ++bk) p4_sample(p, lds, bk, wave, lane); } }
    GSYNC(5);
    if (IN(6)) { pg8::Gemm g{(const bf16_t*)(p->ws + WS_MB), (const bf16_t*)(p->ws + WS_WOUT), NTOK_P, DM, DM}; pg8::StaticOrder S; S.init(NTOK_P, DM, G, (int)blockIdx.x);
      pg8::EpiY E{p->x_prompt, p->x_sample, p->out + O_YP, p->out + O_YS, NTOK_P, NTOK_S, DM};
      pg8::gemm_phase<pg8::EpiY, pg8::StaticOrder>(lds, g, S, E, nullptr);
      if (G == 256) p5_sample(p, lds, (int)blockIdx.x, wave, lane); else if (blockIdx.x == 0) { for (int bk = 0; bk < 256; ++bk) p5_sample(p, lds, bk, wave, lane); } }
}

extern "C" void kernel_launch(void* const* d_in, const int* in_sizes, int n_in, void* d_out, int out_size, void* d_ws, size_t ws_size, hipStream_t stream) {
    static int grid = 0;
    if (grid == 0) {
        if (n_in != 14 || (size_t)out_size != O_END || ws_size < WS_END) { fprintf(stderr, "kernel_launch: unexpected shapes (n_in %d out %d ws %zu)\n", n_in, out_size, ws_size); grid = -1; return; }
        int dev = 0, cus = 0, per_cu = 0;
        (void)hipGetDevice(&dev); (void)hipDeviceGetAttribute(&cus, hipDeviceAttributeMultiprocessorCount, dev);
        if (hipFuncSetAttribute((const void*)fwd_mega, hipFuncAttributeMaxDynamicSharedMemorySize, LDS_BYTES) != hipSuccess) { fprintf(stderr, "kernel_launch: hipFuncSetAttribute failed\n"); grid = -1; return; }
        if (hipOccupancyMaxActiveBlocksPerMultiprocessor(&per_cu, (const void*)fwd_mega, NT, LDS_BYTES) != hipSuccess || per_cu < 1) { fprintf(stderr, "kernel_launch: occupancy query says %d\n", per_cu); per_cu = 1; }
        (void)hipGetLastError();
        grid = cus * 1;
    }
    if (grid < 0) return;
    KArgs a{};
    Params& p = a.p;
    p.x_prompt = (const float*)d_in[0]; p.x_sample = (const float*)d_in[1]; p.cache[0] = (const float*)d_in[2]; p.cache[1] = (const float*)d_in[3]; p.cache[2] = (const float*)d_in[4];
    p.state_conv = (const float*)d_in[5]; p.norm_w = (const float*)d_in[6]; p.w_in = (const float*)d_in[7]; p.q_norm_w = (const float*)d_in[8]; p.k_norm_w = (const float*)d_in[9];
    p.conv_w = (const float*)d_in[10]; p.w_att = (const float*)d_in[11]; p.w_conv = (const float*)d_in[12]; p.w_out = (const float*)d_in[13]; p.out = (float*)d_out; p.ws = (unsigned char*)d_ws;
    if (N_LAUNCHES == 1) {
        a.ph_lo = 0; a.ph_hi = 7;
        (void)hipMemsetAsync((char*)d_ws + WS_CTL, 0, 16384, stream);
        void* args[] = {&a};
        hipError_t e = hipLaunchCooperativeKernel((const void*)fwd_mega, dim3(grid), dim3(NT), args, LDS_BYTES, stream);
        if (e != hipSuccess) fprintf(stderr, "kernel_launch: cooperative launch failed: %s (grid %d)\n", hipGetErrorString(e), grid);
    } else {
        for (int k = 0; k < 7; ++k) { a.ph_lo = k; a.ph_hi = k + 1; hipLaunchKernelGGL(fwd_mega, dim3(grid), dim3(NT), LDS_BYTES, stream, a); }
    }
}
```

```cpp
#include <hip/hip_runtime.h>
#include <hip/hip_cooperative_groups.h>
#include <cstdio>
namespace cg = cooperative_groups;
namespace pg8 {
#define PG8_LAS __attribute__((address_space(3)))
typedef unsigned short bf16_t;
typedef short bf16x8 __attribute__((ext_vector_type(8)));
typedef float f32x4 __attribute__((ext_vector_type(4)));
typedef unsigned u32x4 __attribute__((ext_vector_type(4)));
constexpr int BM = 256, BK = 64, HALF = 128, HTB = HALF * BK * 2  , STAGE_BYTES = 8 * HTB, NXCD = 8, WGM = 8;

__host__ __device__ __forceinline__ int lds_byte(int r, int c) { const int st = (r >> 4) * 2 + (c >> 5), rr = r & 15, cc = c & 31, ob = rr * 64 + cc * 2; return st * 1024 + (ob ^ (((ob >> 9) & 1) << 5)); }
__host__ __device__ __forceinline__ void stage_rc(int b, int& R, int& C) { const int st = b / 1024, sb = b % 1024, swz = sb ^ (((sb >> 9) & 1) << 5); R = (st >> 1) * 16 + swz / 64; C = (st & 1) * 32 + (swz % 64) / 2; }
__host__ __device__ __forceinline__ int perm32(int rho) { const int n = rho >> 4, i = rho & 15; return 8 * (i >> 2) + 4 * n + (i & 3); }

struct Unit { int pm, pn; };
struct Gemm { const bf16_t* A; const bf16_t* Bt; int M, N, K; };

struct StaticOrder {
    int nM, nN, nwg, G, c;
    __host__ __device__ void init(int M, int N, int G_, int c_) { nM = M / BM; nN = N / BM; nwg = nM * nN; G = G_; c = c_; }
    __host__ __device__ bool next(int i, Unit& u) const {
        const long L = (long)i * G + c; if (L >= nwg) return false;
        int wgid = (int)L; { const int q = nwg / NXCD, r = nwg % NXCD, xcd = wgid % NXCD, off = wgid / NXCD; wgid = (xcd < r ? xcd * (q + 1) : r * (q + 1) + (xcd - r) * q) + off; }
        const int nig = WGM * nN, gid = wgid / nig, fm = gid * WGM, gsz = (nM - fm) < WGM ? (nM - fm) : WGM;
        u.pm = fm + ((wgid % nig) % gsz); u.pn = (wgid % nig) / gsz; return true;
    }
    __device__ __forceinline__ void a_ready(const Unit&) const {}
    __device__ __forceinline__ void done(const Unit&) const {}
};
typedef __bf16 bf16x2_t __attribute__((ext_vector_type(2)));
typedef float f32x2_t __attribute__((ext_vector_type(2)));
__device__ __forceinline__ unsigned cvt_pk_bf16(float lo, float hi) { const f32x2_t f = {lo, hi}; return __builtin_bit_cast(unsigned, __builtin_convertvector(f, bf16x2_t)); }
__device__ __forceinline__ float bf_lo(unsigned u) { return __uint_as_float(u << 16); }
__device__ __forceinline__ float bf_hi(unsigned u) { return __uint_as_float(u & 0xffff0000u); }
__device__ __forceinline__ float sigm(float x) { return 1.0f / (1.0f + __expf(-x)); }

struct EpiZ {
    static constexpr bool PERM = true, AFTER_DRAIN = false;
    bf16_t* O; int ldc;
    __device__ __forceinline__ void operator()(const f32x4 (&acc)[2][2][4][2], const Unit& u, int wr, int wc, int fr, int fq) const {
        const int row0 = u.pm * BM + wr * 64 + fr, col0 = u.pn * BM + wc * 32 + 8 * fq;
#pragma unroll
        for (int ai = 0; ai < 2; ++ai)
#pragma unroll
            for (int m = 0; m < 4; ++m) { bf16_t* rowp = O + (size_t)(row0 + ai * HALF + m * 16) * ldc + col0;
#pragma unroll
                for (int bj = 0; bj < 2; ++bj) { const f32x4 v0 = acc[ai][bj][m][0], v1 = acc[ai][bj][m][1];
                    u32x4 w; w.x = cvt_pk_bf16(v0[0], v0[1]); w.y = cvt_pk_bf16(v0[2], v0[3]); w.z = cvt_pk_bf16(v1[0], v1[1]); w.w = cvt_pk_bf16(v1[2], v1[3]);
                    *(u32x4*)(rowp + bj * HALF) = w; } }
    }
};
struct EpiT {
    static constexpr bool PERM = true, AFTER_DRAIN = false;
    bf16_t* T; int ldt; const bf16_t* Z; int ldz; int zoff;
    __device__ __forceinline__ void operator()(const f32x4 (&acc)[2][2][4][2], const Unit& u, int wr, int wc, int fr, int fq) const {
        const int row0 = u.pm * BM + wr * 64 + fr, col0 = u.pn * BM + wc * 32 + 8 * fq;
#pragma unroll
        for (int ai = 0; ai < 2; ++ai) {
            u32x4 lg[4][2];
#pragma unroll
            for (int m = 0; m < 4; ++m)
#pragma unroll
                for (int bj = 0; bj < 2; ++bj) lg[m][bj] = *(const u32x4*)(Z + (size_t)(row0 + ai * HALF + m * 16) * ldz + zoff + col0 + bj * HALF);
#pragma unroll
            for (int m = 0; m < 4; ++m)
#pragma unroll
                for (int bj = 0; bj < 2; ++bj) { const u32x4 l = lg[m][bj]; const f32x4 v0 = acc[ai][bj][m][0], v1 = acc[ai][bj][m][1];
                    u32x4 w;
                    w.x = cvt_pk_bf16(sigm(bf_lo(l.x)) * v0[0], sigm(bf_hi(l.x)) * v0[1]); w.y = cvt_pk_bf16(sigm(bf_lo(l.y)) * v0[2], sigm(bf_hi(l.y)) * v0[3]);
                    w.z = cvt_pk_bf16(sigm(bf_lo(l.z)) * v1[0], sigm(bf_hi(l.z)) * v1[1]); w.w = cvt_pk_bf16(sigm(bf_lo(l.w)) * v1[2], sigm(bf_hi(l.w)) * v1[3]);
                    *(u32x4*)(T + (size_t)(row0 + ai * HALF + m * 16) * ldt + col0 + bj * HALF) = w; }
        }
    }
};
struct EpiM {
    static constexpr bool PERM = true, AFTER_DRAIN = false;
    const bf16_t* T; int ldt; bf16_t* MB; int ldm; const bf16_t* Z; int ldz; int zoff;
    __device__ __forceinline__ void operator()(const f32x4 (&acc)[2][2][4][2], const Unit& u, int wr, int wc, int fr, int fq) const {
        const int row0 = u.pm * BM + wr * 64 + fr, col0 = u.pn * BM + wc * 32 + 8 * fq;
#pragma unroll
        for (int ai = 0; ai < 2; ++ai) {
            u32x4 lg[4][2], tw[4][2];
#pragma unroll
            for (int m = 0; m < 4; ++m)
#pragma unroll
                for (int bj = 0; bj < 2; ++bj) { const size_t row = (size_t)(row0 + ai * HALF + m * 16); const int col = col0 + bj * HALF;
                    lg[m][bj] = *(const u32x4*)(Z + row * ldz + zoff + col); tw[m][bj] = *(const u32x4*)(T + row * ldt + col); }
#pragma unroll
            for (int m = 0; m < 4; ++m)
#pragma unroll
                for (int bj = 0; bj < 2; ++bj) { const u32x4 l = lg[m][bj], t = tw[m][bj]; const f32x4 v0 = acc[ai][bj][m][0], v1 = acc[ai][bj][m][1];
                    u32x4 w;
                    w.x = cvt_pk_bf16(bf_lo(t.x) + sigm(bf_lo(l.x)) * v0[0], bf_hi(t.x) + sigm(bf_hi(l.x)) * v0[1]); w.y = cvt_pk_bf16(bf_lo(t.y) + sigm(bf_lo(l.y)) * v0[2], bf_hi(t.y) + sigm(bf_hi(l.y)) * v0[3]);
                    w.z = cvt_pk_bf16(bf_lo(t.z) + sigm(bf_lo(l.z)) * v1[0], bf_hi(t.z) + sigm(bf_hi(l.z)) * v1[1]); w.w = cvt_pk_bf16(bf_lo(t.w) + sigm(bf_lo(l.w)) * v1[2], bf_hi(t.w) + sigm(bf_hi(l.w)) * v1[3]);
                    *(u32x4*)(MB + (size_t)(row0 + ai * HALF + m * 16) * ldm + col0 + bj * HALF) = w; }
        }
    }
};
struct EpiY {
    static constexpr bool PERM = false, AFTER_DRAIN = false;
    const float* xp; const float* xs; float* yp; float* ys; int np, ns, ld;
    __device__ __forceinline__ void operator()(const f32x4 (&acc)[2][2][4][2], const Unit& u, int wr, int wc, int fr, int fq) const {
        const int row0 = u.pm * BM + wr * 64 + fr, col0 = u.pn * BM + wc * 32 + 4 * fq;
        if (u.pm * BM + BM > np) return;
#pragma unroll
        for (int ai = 0; ai < 2; ++ai) {
            f32x4 xv[4][2][2];
#pragma unroll
            for (int m = 0; m < 4; ++m)
#pragma unroll
                for (int bj = 0; bj < 2; ++bj)
#pragma unroll
                    for (int n = 0; n < 2; ++n) xv[m][bj][n] = *(const f32x4*)(xp + (size_t)(row0 + ai * HALF + m * 16) * ld + col0 + bj * HALF + n * 16);
#pragma unroll
            for (int m = 0; m < 4; ++m)
#pragma unroll
                for (int bj = 0; bj < 2; ++bj)
#pragma unroll
                    for (int n = 0; n < 2; ++n) *(f32x4*)(yp + (size_t)(row0 + ai * HALF + m * 16) * ld + col0 + bj * HALF + n * 16) = xv[m][bj][n] + acc[ai][bj][m][n];
        }
    }
};

struct NoSide { static constexpr bool ON = false; };
struct CopySide {
    static constexpr bool ON = true;
    const float* src0; const float* src1; const float* src2; float* dst0; float* dst1; float* dst2; int q0, qstep, qlim;
    static constexpr int R0 = 32 * 124, R1 = R0 + 32 * 508, R2 = R1 + 32 * 2044;
    __device__ __forceinline__ void rows(int q, const float*& s, float*& d) const {
        if (q < R0) { const int b = q / 124, r = q - b * 124; s = src0 + (size_t)(b * 128 + 4 + r) * 2048; d = dst0 + (size_t)(b * 128 + r) * 2048; }
        else if (q < R1) { const int qq = q - R0, b = qq / 508, r = qq - b * 508; s = src1 + (size_t)(b * 512 + 4 + r) * 2048; d = dst1 + (size_t)(b * 512 + r) * 2048; }
        else { const int qq = q - R1, b = qq / 2044, r = qq - b * 2044; s = src2 + (size_t)(b * 2048 + 4 + r) * 2048; d = dst2 + (size_t)(b * 2048 + r) * 2048; }
    }
};
template <class Epi, class Sched, class Side = NoSide, bool STAMP = false>
__device__ __forceinline__ void gemm_phase(PG8_LAS unsigned char* lds, const Gemm g, const Sched& S, const Epi& E, unsigned long long* stamps, const Side side = Side(), int side_off = 0) {
    const int tid = threadIdx.x, wid = __builtin_amdgcn_readfirstlane(tid >> 6), lane = tid & 63, wr = wid >> 2, wc = wid & 3, fr = lane & 15, fq = lane >> 4;
    const int K = g.K, nt = K / BK;
    int ts_lo = 0, ts_hi = 0, nts = 0; const unsigned long long rt_entry = STAMP ? (unsigned long long)wall_clock64() : 0ull;
#define PG8_STAMP() do { if (STAMP && wid == 0 && nts < 64) { const unsigned long long _c = (unsigned long long)clock64(); \
        ts_lo = (lane == nts) ? (int)(unsigned)_c : ts_lo; ts_hi = (lane == nts) ? (int)(unsigned)(_c >> 32) : ts_hi; ++nts; } } while (0)
    PG8_STAMP();
    unsigned voffA[2], voffB[2];
#pragma unroll
    for (int i = 0; i < 2; ++i) { int R, C; stage_rc(tid * 16 + i * 8192, R, C); const int Rb = Epi::PERM ? ((R & ~31) + perm32(R & 31)) : R;
        voffA[i] = (unsigned)(R * K + C) * 2u; voffB[i] = (unsigned)(Rb * K + C) * 2u; }
    const size_t kstep = (size_t)(BK * 2);
    const size_t hstep = (size_t)HALF * K * 2;
    const size_t tstep = 2 * hstep;
    const unsigned ldsw = (unsigned)wid * 1024u;
    const int aoff = lds_byte(wr * 64 + fr, fq * 8), boff = lds_byte(wc * 32 + fr, fq * 8);
#define PG8_SA(b, h) (((b) * 2 + (h)) * HTB)
#define PG8_SB(b, h) ((4 + (b) * 2 + (h)) * HTB)
#define PG8_STAGE(bufoff, gbase, voff) do { _Pragma("unroll") for (int _i = 0; _i < 2; ++_i) \
        __builtin_amdgcn_global_load_lds((const unsigned*)((const char*)(gbase) + (voff)[_i]), (PG8_LAS unsigned*)(lds + (bufoff) + ldsw + _i * 8192), 16, 0, 0); } while (0)
#define PG8_LDA(dst, b, h) do { _Pragma("unroll") for (int m = 0; m < 4; ++m) _Pragma("unroll") for (int k = 0; k < 2; ++k) dst[m][k] = *(const PG8_LAS bf16x8*)(lds + PG8_SA(b, h) + aoff + m * 2048 + k * 1024); } while (0)
#define PG8_LDB(dst, b, h) do { _Pragma("unroll") for (int n = 0; n < 2; ++n) _Pragma("unroll") for (int k = 0; k < 2; ++k) dst[n][k] = *(const PG8_LAS bf16x8*)(lds + PG8_SB(b, h) + boff + n * 2048 + k * 1024); } while (0)
#define PG8_MMA(ai, bj, At, Bt) do { __builtin_amdgcn_s_setprio(1); _Pragma("unroll") for (int m = 0; m < 4; ++m) _Pragma("unroll") for (int n = 0; n < 2; ++n) _Pragma("unroll") for (int k = 0; k < 2; ++k) \
        acc[ai][bj][m][n] = __builtin_amdgcn_mfma_f32_16x16x32_bf16(Bt[n][k], At[m][k], acc[ai][bj][m][n], 0, 0, 0); __builtin_amdgcn_s_setprio(0); } while (0)
#define PG8_WAIT_V(n) asm volatile("s_waitcnt vmcnt(" #n ")" ::: "memory")
#define PG8_WAIT_L(n) asm volatile("s_waitcnt lgkmcnt(" #n ")" ::: "memory")
#define PG8_BAR __builtin_amdgcn_s_barrier()
#define PG8_SCHED __builtin_amdgcn_sched_barrier(0)
    Unit cur, nxt; int ui = 0;
    int sq_next = 0; float* sd_a = nullptr; float* sd_b = nullptr; f32x4 sv;
    if constexpr (Side::ON) sq_next = side.q0;
#define PG8_SIDE_FILL(slot, dvar) do { if (sq_next < side.qlim) { const float* _s; float* _d; side.rows(sq_next, _s, _d); \
        __builtin_amdgcn_global_load_lds((const unsigned*)(_s + tid * 4), (PG8_LAS unsigned*)(lds + side_off + (slot) * 8192 + ldsw), 16, 0, 0); dvar = _d; sq_next += side.qstep; } else dvar = nullptr; } while (0)
#define PG8_SIDE_READ(slot, dvar) do { if (dvar) sv = *(const PG8_LAS f32x4*)(lds + side_off + (slot) * 8192 + tid * 16); } while (0)
#define PG8_SIDE_STORE(dvar) do { if (dvar) __builtin_nontemporal_store(sv, (f32x4*)dvar + tid); } while (0)
    if (!S.next(0, cur)) return;
    f32x4 acc[2][2][4][2];
#pragma unroll
    for (int a = 0; a < 2; ++a)
#pragma unroll
        for (int b = 0; b < 2; ++b)
#pragma unroll
            for (int m = 0; m < 4; ++m)
#pragma unroll
                for (int n = 0; n < 2; ++n) acc[a][b][m][n] = (f32x4){0.f, 0.f, 0.f, 0.f};
    bf16x8 At[4][2], B0[2][2], B1[2][2];
    const char* cA = (const char*)g.A + (size_t)cur.pm * tstep; const char* cB = (const char*)g.Bt + (size_t)cur.pn * tstep;
    S.a_ready(cur);
    PG8_STAGE(PG8_SB(0, 0), cB, voffB); PG8_STAGE(PG8_SA(0, 0), cA, voffA); PG8_STAGE(PG8_SB(0, 1), cB + hstep, voffB); PG8_STAGE(PG8_SA(0, 1), cA + hstep, voffA);
    if (wr == 1) PG8_BAR;
    PG8_WAIT_V(4); PG8_BAR;
    PG8_STAGE(PG8_SB(1, 0), cB + kstep, voffB); PG8_STAGE(PG8_SA(1, 0), cA + kstep, voffA); PG8_STAGE(PG8_SB(1, 1), cB + hstep + kstep, voffB);
    PG8_WAIT_V(6); PG8_BAR;
    PG8_STAMP();
    for (;;) {
        const bool has_next = S.next(ui + 1, nxt);
        const char* nA = has_next ? (const char*)g.A + (size_t)nxt.pm * tstep : cA; const char* nB = has_next ? (const char*)g.Bt + (size_t)nxt.pn * tstep : cB;
        for (int t = 0; t < nt; t += 2) {
            const bool last = (t == nt - 2);
            const char* a1 = cA + (size_t)(t + 1) * kstep;
            const char* a2 = last ? nA : cA + (size_t)(t + 2) * kstep; const char* b2 = last ? nB : cB + (size_t)(t + 2) * kstep;
            const char* a3 = a2 + kstep; const char* b3 = b2 + kstep;
            if (last && has_next) S.a_ready(nxt);
            if constexpr (Side::ON) { PG8_SIDE_FILL(0, sd_a); PG8_SCHED; }
            PG8_LDB(B0, 0, 0); PG8_SCHED; PG8_LDA(At, 0, 0); PG8_STAGE(PG8_SA(1, 1), a1 + hstep, voffA);
            PG8_WAIT_L(8); PG8_BAR; PG8_WAIT_L(0);
            PG8_MMA(0, 0, At, B0); PG8_BAR; PG8_SCHED;
            PG8_LDB(B1, 0, 1); PG8_STAGE(PG8_SB(0, 0), b2, voffB);
            PG8_BAR; PG8_WAIT_L(0); PG8_MMA(0, 1, At, B1); PG8_BAR;
            PG8_LDA(At, 0, 1); PG8_STAGE(PG8_SA(0, 0), a2, voffA);
            PG8_BAR; PG8_WAIT_L(0); PG8_MMA(1, 0, At, B0); PG8_BAR; PG8_SCHED;
            PG8_STAGE(PG8_SB(0, 1), b2 + hstep, voffB);
            PG8_WAIT_V(6); PG8_BAR; PG8_MMA(1, 1, At, B1); PG8_BAR;
            if constexpr (Side::ON) { PG8_SIDE_READ(0, sd_a); PG8_SCHED; }
            PG8_LDB(B0, 1, 0); PG8_SCHED; PG8_LDA(At, 1, 0); PG8_STAGE(PG8_SA(0, 1), a2 + hstep, voffA);
            PG8_WAIT_L(8); PG8_BAR; PG8_WAIT_L(0);
            if constexpr (Side::ON) { PG8_SIDE_STORE(sd_a); PG8_SCHED; }
            PG8_MMA(0, 0, At, B0); PG8_BAR; PG8_SCHED;
            PG8_LDB(B1, 1, 1); PG8_STAGE(PG8_SB(1, 0), b3, voffB);
            PG8_BAR; PG8_WAIT_L(0); PG8_MMA(0, 1, At, B1); PG8_BAR;
            PG8_LDA(At, 1, 1); PG8_STAGE(PG8_SA(1, 0), a3, voffA);
            PG8_BAR; PG8_WAIT_L(0); PG8_MMA(1, 0, At, B0); PG8_BAR; PG8_SCHED;
            PG8_STAGE(PG8_SB(1, 1), b3 + hstep, voffB);
            PG8_WAIT_V(6); PG8_BAR; PG8_MMA(1, 1, At, B1); PG8_BAR;
        }
        PG8_STAMP();
        if constexpr (!Epi::AFTER_DRAIN) { E(acc, cur, wr, wc, fr, fq); S.done(cur); }
        PG8_STAMP();
        if (!has_next) break;
#pragma unroll
        for (int a = 0; a < 2; ++a)
#pragma unroll
            for (int b = 0; b < 2; ++b)
#pragma unroll
                for (int m = 0; m < 4; ++m)
#pragma unroll
                    for (int n = 0; n < 2; ++n) acc[a][b][m][n] = (f32x4){0.f, 0.f, 0.f, 0.f};
        cur = nxt; cA = nA; cB = nB; ++ui;
    }
    PG8_WAIT_V(0);
    if (wr == 0) PG8_BAR;
    PG8_BAR;
    if constexpr (Side::ON) { while (sq_next < side.qlim) { PG8_SIDE_FILL(0, sd_a); PG8_WAIT_V(0); PG8_SIDE_READ(0, sd_a); PG8_SIDE_STORE(sd_a); } }
    if constexpr (Epi::AFTER_DRAIN) { E.fused(acc, cur, wr, wc, fr, fq, lds, wid, lane); S.done(cur); }
    PG8_STAMP();
    if (STAMP && wid == 0) { stamps[lane] = lane < nts ? (((unsigned long long)(unsigned)ts_hi << 32) | (unsigned)ts_lo) : 0ull;
        if (lane == 62) stamps[62] = rt_entry; if (lane == 63) stamps[63] = (unsigned long long)wall_clock64(); }
#undef PG8_STAMP
#undef PG8_SIDE_FILL
#undef PG8_SIDE_READ
#undef PG8_SIDE_STORE
#undef PG8_SA
#undef PG8_SB
#undef PG8_STAGE
#undef PG8_LDA
#undef PG8_LDB
#undef PG8_MMA
#undef PG8_WAIT_V
#undef PG8_WAIT_L
#undef PG8_BAR
#undef PG8_SCHED
}
}

using pg8::bf16_t; using pg8::bf16x8; using pg8::f32x4; using pg8::u32x4; using pg8::cvt_pk_bf16; using pg8::bf_lo; using pg8::bf_hi;
typedef unsigned u32x2 __attribute__((ext_vector_type(2)));
typedef float f32x2 __attribute__((ext_vector_type(2)));
#define LAS __attribute__((address_space(3)))
constexpr int NT = 512;
constexpr int DM = 2048, SEQ = 8192, NB = 2, NTOK_P = NB * SEQ, DB = 32, DS = 4, NTOK_S = DB * DS, NTOK = NTOK_P + NTOK_S, M_PAD = 16640;
constexpr int N_IN = 22528, D_ATT = 1024, HD = 128, NH = 8, PAST = 16384;
constexpr int OFF_AGATE = 9216, OFF_CONV = 10240, OFF_CGATE = 16384, OFF_MERGE = 18432;
constexpr float EPS = 1e-6f;
constexpr size_t al256(size_t x) { return (x + 255) & ~(size_t)255; }
constexpr size_t WS_XN = 0;
constexpr size_t WS_WIN = al256(WS_XN + (size_t)M_PAD * DM * 2);
constexpr size_t WS_WATT = al256(WS_WIN + (size_t)N_IN * DM * 2);
constexpr size_t WS_WCONV = al256(WS_WATT + (size_t)DM * D_ATT * 2);
constexpr size_t WS_WOUT = al256(WS_WCONV + (size_t)DM * DM * 2);
constexpr size_t WS_Z = al256(WS_WOUT + (size_t)DM * DM * 2);
constexpr size_t WS_OG = al256(WS_Z + (size_t)M_PAD * N_IN * 2);
constexpr size_t WS_LSE = al256(WS_OG + (size_t)3 * NTOK * D_ATT * 2);
constexpr size_t WS_A1 = al256(WS_LSE + (size_t)3 * NTOK * NH * 4);
constexpr size_t WS_A2 = al256(WS_A1 + (size_t)M_PAD * D_ATT * 2);
constexpr size_t WS_T = al256(WS_A2 + (size_t)M_PAD * DM * 2);
constexpr size_t WS_MB = al256(WS_T + (size_t)M_PAD * DM * 4);
constexpr size_t WS_ROPE = al256(WS_MB + (size_t)M_PAD * DM * 2);
constexpr size_t WS_CTL = al256(WS_ROPE + (size_t)(SEQ + DS) * 16 * 8);
constexpr size_t WS_END = WS_CTL + 16384;
constexpr size_t O_YP = 0, O_YS = O_YP + (size_t)NTOK_P * DM, O_KVP0 = O_YS + (size_t)NTOK_S * DM, O_KVP1 = O_KVP0 + (size_t)NB * 128 * 2048, O_KVP2 = O_KVP1 + (size_t)NB * 512 * 2048,
                 O_CVP = O_KVP2 + (size_t)NB * 2048 * 2048, O_KVS0 = O_CVP + (size_t)NB * 2 * DM, O_KVS1 = O_KVS0 + (size_t)DB * 128 * 2048, O_KVS2 = O_KVS1 + (size_t)DB * 512 * 2048,
                 O_CVS = O_KVS2 + (size_t)DB * 2048 * 2048, O_END = O_CVS + (size_t)DB * 2 * DM;
constexpr int LDS_BYTES = 147456;
constexpr int KS_STRIDE = 272;
constexpr int VT_STRIDE_DW = 130;
constexpr int VT_OFF = 256 * KS_STRIDE;
constexpr int NW_OFF = VT_OFF + 128 * VT_STRIDE_DW * 4;
static_assert(NW_OFF + 6 * 128 * 4 <= LDS_BYTES - 16, "lds");
constexpr int XB_LDS_OFF = LDS_BYTES - 16;

struct Params {
    const float* x_prompt; const float* x_sample; const float* cache[3]; const float* state_conv; const float* norm_w; const float* w_in; const float* q_norm_w; const float* k_norm_w;
    const float* conv_w; const float* w_att; const float* w_conv; const float* w_out; float* out; unsigned char* ws;
};

typedef const __attribute__((address_space(4))) Params* KP;
__device__ __constant__ float c_rope_inv[16] = {1.000000000e+00f, 4.403665960e-01f, 1.939227432e-01f, 8.539710194e-02f, 3.760603070e-02f, 1.656043902e-02f, 7.292664610e-03f, 3.211445874e-03f,
    1.414213562e-03f, 6.227723788e-04f, 2.742481884e-04f, 1.207697351e-04f, 5.318296098e-05f, 2.341999971e-05f, 1.031338616e-05f, 4.541670478e-06f};

constexpr float kRopeInv[16] = {1.000000000e+00f, 4.403665960e-01f, 1.939227432e-01f, 8.539710194e-02f, 3.760603070e-02f, 1.656043902e-02f, 7.292664610e-03f, 3.211445874e-03f,
    1.414213562e-03f, 6.227723788e-04f, 2.742481884e-04f, 1.207697351e-04f, 5.318296098e-05f, 2.341999971e-05f, 1.031338616e-05f, 4.541670478e-06f};
__device__ __forceinline__ f32x2 rope_cs(float pos, float inv) {
    const float rev = (pos * inv) * 0.15915494309189535f, fr = rev - rintf(rev);
    return (f32x2){__builtin_amdgcn_cosf(fr), __builtin_amdgcn_sinf(fr)};
}
__device__ __forceinline__ float wave_sum(float v) {
#pragma unroll
    for (int o = 32; o >= 1; o >>= 1) v += __shfl_xor(v, o);
    return v;
}
__device__ __forceinline__ float siluf(float x) { return x / (1.0f + __expf(-x)); }

__device__ __forceinline__ void p0_rmsnorm(KP p, int G, int wave, int lane) {
    bf16_t* XN = (bf16_t*)(p->ws + WS_XN);
    for (int row = blockIdx.x * 8 + wave; row < M_PAD; row += G * 8) {
        bf16_t* dst = XN + (size_t)row * DM;
        if (row >= NTOK) {
#pragma unroll
            for (int i = 0; i < 8; ++i) *(u32x2*)(dst + (i * 64 + lane) * 4) = (u32x2){0u, 0u};
            continue;
        }
        const float* src = row < NTOK_P ? p->x_prompt + (size_t)row * DM : p->x_sample + (size_t)(row - NTOK_P) * DM;
        f32x4 v[8]; float ss = 0.f;
#pragma unroll
        for (int i = 0; i < 8; ++i) { v[i] = *(const f32x4*)(src + (i * 64 + lane) * 4); ss += v[i][0] * v[i][0] + v[i][1] * v[i][1] + v[i][2] * v[i][2] + v[i][3] * v[i][3]; }
        ss = wave_sum(ss);
        const float rstd = rsqrtf(ss * (1.0f / DM) + EPS);
#pragma unroll
        for (int i = 0; i < 8; ++i) { const f32x4 w = *(const f32x4*)(p->norm_w + (i * 64 + lane) * 4);
            u32x2 o; o.x = cvt_pk_bf16(v[i][0] * rstd * w[0], v[i][1] * rstd * w[1]); o.y = cvt_pk_bf16(v[i][2] * rstd * w[2], v[i][3] * rstd * w[3]);
            *(u32x2*)(dst + (i * 64 + lane) * 4) = o; }
    }
}
__device__ __forceinline__ void p0_transpose(const float* W, bf16_t* Wt, int K, int N, LAS float* tile, int G, int tid) {
    const int tk = K / 64, tn = N / 64, ntile = tk * tn;
    for (int t = blockIdx.x; t < ntile; t += G) {
        const int k0 = (t % tk) * 64, n0 = (t / tk) * 64;
#pragma unroll
        for (int i = 0; i < 2; ++i) { const int k = (tid >> 4) + 32 * i, n4 = (tid & 15) * 4;
            const f32x4 v = *(const f32x4*)(W + (size_t)(k0 + k) * N + n0 + n4);
            tile[k * 65 + n4 + 0] = v[0]; tile[k * 65 + n4 + 1] = v[1]; tile[k * 65 + n4 + 2] = v[2]; tile[k * 65 + n4 + 3] = v[3]; }
        __syncthreads();
        { const int n = tid >> 3, k8 = (tid & 7) * 8; float f[8];
#pragma unroll
          for (int j = 0; j < 8; ++j) f[j] = tile[(k8 + j) * 65 + n];
          u32x4 o; o.x = cvt_pk_bf16(f[0], f[1]); o.y = cvt_pk_bf16(f[2], f[3]); o.z = cvt_pk_bf16(f[4], f[5]); o.w = cvt_pk_bf16(f[6], f[7]);
          *(u32x4*)(Wt + (size_t)(n0 + n) * K + k0 + k8) = o; }
        __syncthreads();
    }
}
__device__ __forceinline__ void p0_rope(KP p, int G, int tid) {
    f32x2* R = (f32x2*)(p->ws + WS_ROPE);
    for (int i = blockIdx.x * NT + tid; i < (SEQ + DS) * 16; i += G * NT) {
        const int pi = i >> 4, f = i & 15; const float pos = (float)(pi < SEQ ? pi : PAST + (pi - SEQ));
        const float ang = pos * c_rope_inv[f];
        const double t = (double)ang * 0.15915494309189533577; const float fr = (float)(t - rint(t));
        R[i] = (f32x2){__builtin_amdgcn_cosf(fr), __builtin_amdgcn_sinf(fr)};
    }
}

__device__ __forceinline__ void attn_ld_kv(const bf16_t* Z, int b, int colK, int colV, int dsh, int r, int blk, int tid, int wave, int lane, u32x4 (&kraw)[4], u32x4 (&vraw)[2][2]) {
    { const int s = ((blk * 128 + (tid >> 2)) << dsh) + r; const u32x4* src = (const u32x4*)(Z + (size_t)(b * SEQ + s) * N_IN + colK + (tid & 3) * 32);
#pragma unroll
      for (int i = 0; i < 4; ++i) kraw[i] = src[i]; }
    const int dc = (lane & 3) + 4 * (wave & 3);
#pragma unroll
    for (int ps = 0; ps < 2; ++ps) { const int kp = ps * 32 + (wave >> 2) * 16 + (lane >> 2), s0 = ((blk * 128 + 2 * kp) << dsh) + r, s1 = ((blk * 128 + 2 * kp + 1) << dsh) + r;
        vraw[ps][0] = *(const u32x4*)(Z + (size_t)(b * SEQ + s0) * N_IN + colV + dc * 8); vraw[ps][1] = *(const u32x4*)(Z + (size_t)(b * SEQ + s1) * N_IN + colV + dc * 8); }
}
__device__ __forceinline__ void attn_st_kv(KP p, LAS unsigned char* lds, int slot, bool zero, bool last, float* okv, int g, int b, int h, int W, int dsh, int r, int blk, int tid, int wave, int lane,
                                           const u32x4 (&kraw)[4], const u32x4 (&vraw)[2][2]) {
    const f32x2* ROPE = (const f32x2*)(p->ws + WS_ROPE);
    { const int row = tid >> 2, c = tid & 3, s = ((blk * 128 + row) << dsh) + r;
      float x[32];
#pragma unroll
      for (int i = 0; i < 4; ++i) { u32x4 v = kraw[i]; if (zero) v = (u32x4){0u, 0u, 0u, 0u};
          x[i * 8 + 0] = bf_lo(v.x); x[i * 8 + 1] = bf_hi(v.x); x[i * 8 + 2] = bf_lo(v.y); x[i * 8 + 3] = bf_hi(v.y); x[i * 8 + 4] = bf_lo(v.z); x[i * 8 + 5] = bf_hi(v.z); x[i * 8 + 6] = bf_lo(v.w); x[i * 8 + 7] = bf_hi(v.w); }
      float ss = 0.f;
#pragma unroll
      for (int j = 0; j < 32; ++j) ss += x[j] * x[j];
      ss += __shfl_xor(ss, 1); ss += __shfl_xor(ss, 2);
      const float rstd = rsqrtf(ss * (1.0f / HD) + EPS);
      const LAS float* kw = (const LAS float*)(lds + NW_OFF) + g * HD + c * 32;
#pragma unroll
      for (int j = 0; j < 32; ++j) x[j] = x[j] * rstd * kw[j];
      if (c == 0 && !zero) {
#pragma unroll
          for (int i = 0; i < 16; ++i) { const f32x2 cs = rope_cs((float)s, kRopeInv[i]); const float a = x[i], bb = x[i + 16]; x[i] = a * cs.x - bb * cs.y; x[i + 16] = bb * cs.x + a * cs.y; }
      }
      LAS u32x4* kd = (LAS u32x4*)(lds + (slot * 128 + row) * KS_STRIDE + c * 64);
#pragma unroll
      for (int i = 0; i < 4; ++i) { u32x4 o; o.x = cvt_pk_bf16(x[i * 8 + 0], x[i * 8 + 1]); o.y = cvt_pk_bf16(x[i * 8 + 2], x[i * 8 + 3]); o.z = cvt_pk_bf16(x[i * 8 + 4], x[i * 8 + 5]); o.w = cvt_pk_bf16(x[i * 8 + 6], x[i * 8 + 7]); kd[i] = o; }
      if (last) {
          float* d = okv + ((size_t)((b * W + (s - (SEQ - W))) * 2 + 0) * NH + h) * HD + c * 32;
#pragma unroll
          for (int i = 0; i < 8; ++i) *(f32x4*)(d + i * 4) = (f32x4){x[i * 4], x[i * 4 + 1], x[i * 4 + 2], x[i * 4 + 3]};
      }
    }
    __builtin_amdgcn_sched_barrier(0);
    LAS unsigned* vt = (LAS unsigned*)(lds + VT_OFF);
    const int dc = (lane & 3) + 4 * (wave & 3);
#pragma unroll
    for (int ps = 0; ps < 2; ++ps) { const int kp = ps * 32 + (wave >> 2) * 16 + (lane >> 2);
        u32x4 v0 = vraw[ps][0], v1 = vraw[ps][1];
        if (zero) { v0 = (u32x4){0u, 0u, 0u, 0u}; v1 = v0; }
        LAS unsigned* d = vt + (dc * 8) * VT_STRIDE_DW + slot * 64 + kp;
        d[0 * VT_STRIDE_DW] = (v0.x & 0xffffu) | (v1.x << 16); d[1 * VT_STRIDE_DW] = (v0.x >> 16) | (v1.x & 0xffff0000u);
        d[2 * VT_STRIDE_DW] = (v0.y & 0xffffu) | (v1.y << 16); d[3 * VT_STRIDE_DW] = (v0.y >> 16) | (v1.y & 0xffff0000u);
        d[4 * VT_STRIDE_DW] = (v0.z & 0xffffu) | (v1.z << 16); d[5 * VT_STRIDE_DW] = (v0.z >> 16) | (v1.z & 0xffff0000u);
        d[6 * VT_STRIDE_DW] = (v0.w & 0xffffu) | (v1.w << 16); d[7 * VT_STRIDE_DW] = (v0.w >> 16) | (v1.w & 0xffff0000u);
        if (last) {
            const int s0 = ((blk * 128 + 2 * kp) << dsh) + r, s1 = ((blk * 128 + 2 * kp + 1) << dsh) + r;
            float* d0 = okv + ((size_t)((b * W + (s0 - (SEQ - W))) * 2 + 1) * NH + h) * HD + dc * 8;
            float* d1 = okv + ((size_t)((b * W + (s1 - (SEQ - W))) * 2 + 1) * NH + h) * HD + dc * 8;
            *(f32x4*)d0 = (f32x4){bf_lo(v0.x), bf_hi(v0.x), bf_lo(v0.y), bf_hi(v0.y)}; *(f32x4*)(d0 + 4) = (f32x4){bf_lo(v0.z), bf_hi(v0.z), bf_lo(v0.w), bf_hi(v0.w)};
            *(f32x4*)d1 = (f32x4){bf_lo(v1.x), bf_hi(v1.x), bf_lo(v1.y), bf_hi(v1.y)}; *(f32x4*)(d1 + 4) = (f32x4){bf_lo(v1.z), bf_hi(v1.z), bf_lo(v1.w), bf_hi(v1.w)};
        }
    }
}
__device__ __forceinline__ void attn_prompt_chunk(KP p, LAS unsigned char* lds, int g, int b, int r, int h, int qb0, int nblk, int tid, int wave, int lane) {
    const bf16_t* Z = (const bf16_t*)(p->ws + WS_Z);
    const f32x2* ROPE = (const f32x2*)(p->ws + WS_ROPE);
    const int dsh = 2 * g, nb = 64 >> dsh;
    const int W = 128 << dsh;
    const int colQ = ((g * 3 + 0) * NH + h) * HD, colK = ((g * 3 + 1) * NH + h) * HD, colV = ((g * 3 + 2) * NH + h) * HD;
    float* okv = p->out + (g == 0 ? O_KVP0 : (g == 1 ? O_KVP1 : O_KVP2));
    const int fr = lane & 15, fq = lane >> 4;
    LAS unsigned* vt = (LAS unsigned*)(lds + VT_OFF);
    u32x4 kraw[4], vraw[2][2], qraw[4];
    attn_ld_kv(Z, b, colK, colV, dsh, r, qb0 > 0 ? qb0 - 1 : 0, tid, wave, lane, kraw, vraw);
    attn_st_kv(p, lds, 0, qb0 == 0, false, okv, g, b, h, W, dsh, r, qb0 > 0 ? qb0 - 1 : 0, tid, wave, lane, kraw, vraw);
    attn_ld_kv(Z, b, colK, colV, dsh, r, qb0, tid, wave, lane, kraw, vraw);
#pragma unroll 1
    for (int n = 0; n < nblk; ++n) {
        const int qb = qb0 + n, ps = n & 1, cs = ps ^ 1, kbase = qb * 128 - 128;
        const int qi = wave * 16 + fr, sq = ((qb * 128 + qi) << dsh) + r;
        const size_t tokq = (size_t)b * SEQ + sq;
#pragma unroll
        for (int ks = 0; ks < 4; ++ks) qraw[ks] = *(const u32x4*)(Z + tokq * N_IN + colQ + fq * 8 + ks * 32);
        attn_st_kv(p, lds, cs, false, qb == nb - 1, okv, g, b, h, W, dsh, r, qb, tid, wave, lane, kraw, vraw);
        __builtin_amdgcn_sched_barrier(0);
        bf16x8 qf[4];
        { float f[4][8]; float ss = 0.f;
#pragma unroll
          for (int ks = 0; ks < 4; ++ks) { const u32x4 v = qraw[ks];
              f[ks][0] = bf_lo(v.x); f[ks][1] = bf_hi(v.x); f[ks][2] = bf_lo(v.y); f[ks][3] = bf_hi(v.y); f[ks][4] = bf_lo(v.z); f[ks][5] = bf_hi(v.z); f[ks][6] = bf_lo(v.w); f[ks][7] = bf_hi(v.w);
#pragma unroll
              for (int j = 0; j < 8; ++j) ss += f[ks][j] * f[ks][j]; }
          ss += __shfl_xor(ss, 16); ss += __shfl_xor(ss, 32);
          const float rstd = rsqrtf(ss * (1.0f / HD) + EPS);
          const LAS float* qw = (const LAS float*)(lds + NW_OFF) + 3 * HD + g * HD + fq * 8;
#pragma unroll
          for (int ks = 0; ks < 4; ++ks)
#pragma unroll
              for (int j = 0; j < 8; ++j) f[ks][j] = f[ks][j] * rstd * qw[ks * 32 + j];
#pragma unroll
          for (int j = 0; j < 8; ++j) { const float own = f[0][j], oth = __shfl_xor(own, 32); const f32x2 csn = rope_cs((float)sq, (fq & 1) ? kRopeInv[8 + j] : kRopeInv[j]);
              f[0][j] = (fq < 2) ? own * csn.x - oth * csn.y : own * csn.x + oth * csn.y; }
          const float sc = 0.08838834764831845f * 1.4426950408889634f;
#pragma unroll
          for (int ks = 0; ks < 4; ++ks) { u32x4 o; o.x = cvt_pk_bf16(f[ks][0] * sc, f[ks][1] * sc); o.y = cvt_pk_bf16(f[ks][2] * sc, f[ks][3] * sc); o.z = cvt_pk_bf16(f[ks][4] * sc, f[ks][5] * sc); o.w = cvt_pk_bf16(f[ks][6] * sc, f[ks][7] * sc);
              qf[ks] = __builtin_bit_cast(bf16x8, o); }
        }
        __builtin_amdgcn_sched_barrier(0);
        if (n < nblk - 1) {
            attn_ld_kv(Z, b, colK, colV, dsh, r, qb + 1, tid, wave, lane, kraw, vraw);
        }
        __builtin_amdgcn_sched_barrier(0);
        __syncthreads();
        f32x4 sacc[9];
        __builtin_amdgcn_s_setprio(1);
#pragma unroll
        for (int kt = 0; kt < 9; ++kt) { sacc[kt] = (f32x4){0.f, 0.f, 0.f, 0.f};
            const int T = wave + kt, lrow = ((T < 8 ? ps : cs) * 128) + (T & 7) * 16 + fr;
            const LAS unsigned char* kr = lds + lrow * KS_STRIDE + fq * 16;
#pragma unroll
            for (int ks = 0; ks < 4; ++ks) { const bf16x8 a = *(const LAS bf16x8*)(kr + ks * 64); sacc[kt] = __builtin_amdgcn_mfma_f32_16x16x32_bf16(a, qf[ks], sacc[kt], 0, 0, 0); }
            if ((kt % 3) == 2) __builtin_amdgcn_sched_barrier(0);
        }
        __builtin_amdgcn_s_setprio(0);
        float mx = -3.0e38f;
#pragma unroll
        for (int kt = 0; kt < 9; ++kt)
#pragma unroll
            for (int e = 0; e < 4; ++e) { const int kj = (wave + kt) * 16 + fq * 4 + e; const bool ok = (kj >= qi) && (kj <= qi + 128) && (kbase + kj >= 0);
                sacc[kt][e] = ok ? sacc[kt][e] : -3.0e38f; mx = fmaxf(mx, sacc[kt][e]); }
        mx = fmaxf(mx, __shfl_xor(mx, 16)); mx = fmaxf(mx, __shfl_xor(mx, 32));
        float sum = 0.f;
#pragma unroll
        for (int kt = 0; kt < 9; ++kt)
#pragma unroll
            for (int e = 0; e < 4; ++e) { const float pe = __builtin_amdgcn_exp2f(sacc[kt][e] - mx); sacc[kt][e] = pe; sum += pe; }
        sum += __shfl_xor(sum, 16); sum += __shfl_xor(sum, 32);
        const float inv = 1.0f / sum;
        if (fq == 0) ((float*)(p->ws + WS_LSE))[((size_t)g * NTOK + tokq) * NH + h] = (mx + __builtin_amdgcn_logf(sum)) * 0.6931471805599453f;
        bf16x8 pf[5];
#pragma unroll
        for (int kk = 0; kk < 5; ++kk) { u32x4 o; o.x = cvt_pk_bf16(sacc[2 * kk][0] * inv, sacc[2 * kk][1] * inv); o.y = cvt_pk_bf16(sacc[2 * kk][2] * inv, sacc[2 * kk][3] * inv);
            if (kk < 4) { o.z = cvt_pk_bf16(sacc[2 * kk + 1][0] * inv, sacc[2 * kk + 1][1] * inv); o.w = cvt_pk_bf16(sacc[2 * kk + 1][2] * inv, sacc[2 * kk + 1][3] * inv); } else { o.z = 0u; o.w = 0u; }
            pf[kk] = __builtin_bit_cast(bf16x8, o); }
        bf16_t* og = (bf16_t*)(p->ws + WS_OG) + ((size_t)g * NTOK + tokq) * D_ATT + h * HD + fq * 4;
        int vcol[5][2];
#pragma unroll
        for (int kk = 0; kk < 5; ++kk) { const int T0 = wave + 2 * kk, T1 = T0 + 1;
            vcol[kk][0] = (T0 < 8 ? ps : cs) * 64 + (T0 & 7) * 8 + fq * 2; vcol[kk][1] = (T1 < 8 ? ps : cs) * 64 + (T1 & 7) * 8 + fq * 2; }
#pragma unroll 2
        for (int dt = 0; dt < 8; ++dt) { f32x4 oacc = (f32x4){0.f, 0.f, 0.f, 0.f};
            const LAS unsigned* vr = vt + (dt * 16 + fr) * VT_STRIDE_DW;
#pragma unroll
            for (int kk = 0; kk < 5; ++kk) { u32x4 a; const u32x2 lo = *(const LAS u32x2*)(vr + vcol[kk][0]); a.x = lo.x; a.y = lo.y;
                if (kk < 4) { const u32x2 hi = *(const LAS u32x2*)(vr + vcol[kk][1]); a.z = hi.x; a.w = hi.y; } else { a.z = 0u; a.w = 0u; }
                oacc = __builtin_amdgcn_mfma_f32_16x16x32_bf16(__builtin_bit_cast(bf16x8, a), pf[kk], oacc, 0, 0, 0); }
            u32x2 o; o.x = cvt_pk_bf16(oacc[0], oacc[1]); o.y = cvt_pk_bf16(oacc[2], oacc[3]);
            *(u32x2*)(og + dt * 16) = o; }
        __syncthreads();
    }
}
__device__ __forceinline__ void attn_sample_item(KP p, LAS unsigned char* lds, int item, int tid, int wave, int lane) {
    const bf16_t* Z = (const bf16_t*)(p->ws + WS_Z);
    const f32x2* ROPE = (const f32x2*)(p->ws + WS_ROPE);
    const int h = item & 7, g = (item >> 3) % 3, b = item / 24;
    const int dsh = 2 * g, W = 128 << dsh, dil = 1 << dsh;
    const float* cache = p->cache[g] + (size_t)b * W * 2048;
    float* okv = p->out + (g == 0 ? O_KVS0 : (g == 1 ? O_KVS1 : O_KVS2)) + (size_t)b * W * 2048;
    LAS float* qn = (LAS float*)lds;
    LAS float* kn = qn + 512;
    LAS float* vn = kn + 512;
    LAS float* sc = vn + 512;
    { const int t = wave >> 1, kind = wave & 1; const size_t row = (size_t)NTOK_P + b * DS + t;
      const int col = ((g * 3 + kind) * NH + h) * HD + 2 * lane;
      const unsigned u = *(const unsigned*)(Z + row * N_IN + col);
      float x0 = bf_lo(u), x1 = bf_hi(u);
      const float ss = wave_sum(x0 * x0 + x1 * x1);
      const float rstd = rsqrtf(ss * (1.0f / HD) + EPS);
      const float* nw = (kind == 0 ? p->q_norm_w : p->k_norm_w) + g * HD + 2 * lane;
      x0 = x0 * rstd * nw[0]; x1 = x1 * rstd * nw[1];
      const float o0 = __shfl_xor(x0, 8), o1 = __shfl_xor(x1, 8);
      if (lane < 16) { const int i0 = 2 * (lane & 7); const f32x2 c0 = ROPE[(SEQ + t) * 16 + i0], c1 = ROPE[(SEQ + t) * 16 + i0 + 1];
          if (lane < 8) { x0 = x0 * c0.x - o0 * c0.y; x1 = x1 * c1.x - o1 * c1.y; } else { x0 = x0 * c0.x + o0 * c0.y; x1 = x1 * c1.x + o1 * c1.y; } }
      if (kind == 0) { qn[t * 128 + 2 * lane] = x0 * 0.08838834764831845f; qn[t * 128 + 2 * lane + 1] = x1 * 0.08838834764831845f; }
      else { kn[t * 128 + 2 * lane] = x0; kn[t * 128 + 2 * lane + 1] = x1;
          const unsigned uv = *(const unsigned*)(Z + row * N_IN + ((g * 3 + 2) * NH + h) * HD + 2 * lane);
          const float v0 = bf_lo(uv), v1 = bf_hi(uv);
          vn[t * 128 + 2 * lane] = v0; vn[t * 128 + 2 * lane + 1] = v1;
          float* dk = okv + ((size_t)((W - DS + t) * 2 + 0) * NH + h) * HD + 2 * lane; float* dv = okv + ((size_t)((W - DS + t) * 2 + 1) * NH + h) * HD + 2 * lane;
          *(f32x2*)dk = (f32x2){x0, x1}; *(f32x2*)dv = (f32x2){v0, v1}; }
    }
    __syncthreads();
    const int lg = tid >> 4, l16 = tid & 15, t = lg >> 3, sub = lg & 7;
    f32x4 q0, q1; { const LAS float* qp = qn + t * 128 + l16 * 8; q0 = *(const LAS f32x4*)qp; q1 = *(const LAS f32x4*)(qp + 4); }
    float m_run = -3.0e38f, l_run = 0.f; f32x4 o0 = (f32x4){0.f, 0.f, 0.f, 0.f}, o1 = o0;
#pragma unroll
    for (int chunk = 0; chunk < 2; ++chunk) {
        constexpr int NS0 = 9; const int sbase = chunk * NS0;
        f32x4 kr[NS0][2], vr[NS0][2];
#pragma unroll
        for (int i = 0; i < NS0; ++i) { const int j = sub + 8 * (sbase + i);
            if (chunk == 1 && i == NS0 - 1) { kr[i][0] = kr[i][1] = vr[i][0] = vr[i][1] = (f32x4){0.f, 0.f, 0.f, 0.f}; continue; }
            int idx = W + t - j * dil; idx = (j <= 128 && idx >= 0) ? idx : 0;
            if (idx >= W) { const LAS float* kp = kn + (idx - W) * 128 + l16 * 8; const LAS float* vp = vn + (idx - W) * 128 + l16 * 8;
                kr[i][0] = *(const LAS f32x4*)kp; kr[i][1] = *(const LAS f32x4*)(kp + 4); vr[i][0] = *(const LAS f32x4*)vp; vr[i][1] = *(const LAS f32x4*)(vp + 4); }
            else { const float* kp = cache + ((size_t)(idx * 2 + 0) * NH + h) * HD + l16 * 8; const float* vp = kp + NH * HD;
                kr[i][0] = *(const f32x4*)kp; kr[i][1] = *(const f32x4*)(kp + 4); vr[i][0] = *(const f32x4*)vp; vr[i][1] = *(const f32x4*)(vp + 4); } }
#pragma unroll
        for (int i = 0; i < NS0; ++i) { const int j = sub + 8 * (sbase + i);
            if (chunk == 1 && i == NS0 - 1) continue;
            const bool valid = (j <= 128) && (W + t - j * dil >= 0);
            float d = kr[i][0][0] * q0[0] + kr[i][0][1] * q0[1] + kr[i][0][2] * q0[2] + kr[i][0][3] * q0[3] + kr[i][1][0] * q1[0] + kr[i][1][1] * q1[1] + kr[i][1][2] * q1[2] + kr[i][1][3] * q1[3];
            d += __shfl_xor(d, 1); d += __shfl_xor(d, 2); d += __shfl_xor(d, 4); d += __shfl_xor(d, 8);
            if (valid) { const float mn = fmaxf(m_run, d), corr = __expf(m_run - mn), pe = __expf(d - mn);
                l_run = l_run * corr + pe; o0 = o0 * corr + vr[i][0] * pe; o1 = o1 * corr + vr[i][1] * pe; m_run = mn; } }
    }
    LAS float* po = (LAS float*)(lds + 8192);
    LAS float* pm = po + 32 * 128;
    *(LAS f32x4*)(po + lg * 128 + l16 * 8) = o0; *(LAS f32x4*)(po + lg * 128 + l16 * 8 + 4) = o1;
    if (l16 == 0) { pm[lg] = m_run; pm[32 + lg] = l_run; }
    __syncthreads();
    { const int tt = tid >> 7, d = tid & 127; float M = -3.0e38f;
#pragma unroll
      for (int u = 0; u < 8; ++u) M = fmaxf(M, pm[tt * 8 + u]);
      float L = 0.f, O = 0.f;
#pragma unroll
      for (int u = 0; u < 8; ++u) { const float w = __expf(pm[tt * 8 + u] - M); L += pm[32 + tt * 8 + u] * w; O += po[(tt * 8 + u) * 128 + d] * w; }
      O /= L;
      bf16_t* og = (bf16_t*)(p->ws + WS_OG) + ((size_t)g * NTOK + NTOK_P + b * DS + tt) * D_ATT + h * HD + d;
      const float on = __shfl_down(O, 1);
      if ((lane & 1) == 0) *(unsigned*)og = cvt_pk_bf16(O, on);
      if (d == 0) ((float*)(p->ws + WS_LSE))[((size_t)g * NTOK + NTOK_P + b * DS + tt) * NH + h] = M + __logf(L);
    }
    __syncthreads();
}

__device__ __forceinline__ void unpack8(const u32x4 v, float (&f)[8]) { f[0] = bf_lo(v.x); f[1] = bf_hi(v.x); f[2] = bf_lo(v.y); f[3] = bf_hi(v.y); f[4] = bf_lo(v.z); f[5] = bf_hi(v.z); f[6] = bf_lo(v.w); f[7] = bf_hi(v.w); }
__device__ __forceinline__ u32x4 pack8(const float (&f)[8]) { u32x4 o; o.x = cvt_pk_bf16(f[0], f[1]); o.y = cvt_pk_bf16(f[2], f[3]); o.z = cvt_pk_bf16(f[4], f[5]); o.w = cvt_pk_bf16(f[6], f[7]); return o; }
template <bool DO_A1, bool DO_A2> __device__ __forceinline__ void p3_rows(KP p, int G, int wave, int lane, int pass_lo, int pass_hi) {
    const bf16_t* Z = (const bf16_t*)(p->ws + WS_Z);
    const bf16_t* OG = (const bf16_t*)(p->ws + WS_OG);
    const float* LSE = (const float*)(p->ws + WS_LSE);
    bf16_t* A1 = (bf16_t*)(p->ws + WS_A1); bf16_t* A2 = (bf16_t*)(p->ws + WS_A2);
    for (int pass = pass_lo; pass < pass_hi; ++pass) { const int row = blockIdx.x * 8 + wave + pass * G * 8; if (row >= M_PAD) break;
        if (row >= NTOK) {
            if (DO_A1) {
#pragma unroll
            for (int i = 0; i < 2; ++i) *(u32x4*)(A1 + (size_t)row * D_ATT + (lane + 64 * i) * 8) = (u32x4){0u, 0u, 0u, 0u}; }
            if (DO_A2) {
#pragma unroll
            for (int i = 0; i < 4; ++i) *(u32x4*)(A2 + (size_t)row * DM + (lane + 64 * i) * 8) = (u32x4){0u, 0u, 0u, 0u}; }
            continue;
        }
        const bf16_t* zr = Z + (size_t)row * N_IN;
        if (DO_A1)
#pragma unroll
        for (int i = 0; i < 2; ++i) { const int ch = lane + 64 * i, col = ch * 8, h = ch >> 4;
            const float l0 = LSE[((size_t)0 * NTOK + row) * NH + h], l1 = LSE[((size_t)1 * NTOK + row) * NH + h], l2 = LSE[((size_t)2 * NTOK + row) * NH + h];
            const float mx = fmaxf(l0, fmaxf(l1, l2)); float w0 = __expf(l0 - mx), w1 = __expf(l1 - mx), w2 = __expf(l2 - mx); const float inv = 1.0f / (w0 + w1 + w2); w0 *= inv; w1 *= inv; w2 *= inv;
            float o0[8], o1[8], o2[8], ga[8], r[8];
            unpack8(*(const u32x4*)(OG + ((size_t)0 * NTOK + row) * D_ATT + col), o0); unpack8(*(const u32x4*)(OG + ((size_t)1 * NTOK + row) * D_ATT + col), o1);
            unpack8(*(const u32x4*)(OG + ((size_t)2 * NTOK + row) * D_ATT + col), o2); unpack8(*(const u32x4*)(zr + OFF_AGATE + col), ga);
#pragma unroll
            for (int j = 0; j < 8; ++j) r[j] = (w0 * o0[j] + w1 * o1[j] + w2 * o2[j]) * siluf(ga[j]);
            *(u32x4*)(A1 + (size_t)row * D_ATT + col) = pack8(r); }
        const bool samp = row >= NTOK_P; const int pos = samp ? ((row - NTOK_P) & (DS - 1)) : (row & (SEQ - 1)); const int bs = samp ? (row - NTOK_P) >> 2 : row >> 13;
        if (DO_A2)
#pragma unroll
        for (int i = 0; i < 4; ++i) { const int col = (lane + 64 * i) * 8;
            float hh[8], cc[8], bb[8], gg[8], u0[8], u1[8], u2[8], r[8];
            unpack8(*(const u32x4*)(zr + OFF_CONV + col), hh); unpack8(*(const u32x4*)(zr + OFF_CONV + 2 * DM + col), cc);
            unpack8(*(const u32x4*)(zr + OFF_CONV + DM + col), bb); unpack8(*(const u32x4*)(zr + OFF_CGATE + col), gg);
#pragma unroll
            for (int j = 0; j < 8; ++j) u0[j] = cc[j] * hh[j];
#pragma unroll
            for (int k = 1; k <= 2; ++k) { float (&uk)[8] = (k == 1) ? u1 : u2;
                if (pos - k >= 0) { float h2[8], c2[8]; unpack8(*(const u32x4*)(zr - (size_t)k * N_IN + OFF_CONV + col), h2); unpack8(*(const u32x4*)(zr - (size_t)k * N_IN + OFF_CONV + 2 * DM + col), c2);
#pragma unroll
                    for (int j = 0; j < 8; ++j) uk[j] = c2[j] * h2[j]; }
                else if (samp) { const float* st = p->state_conv + ((size_t)bs * 2 + (2 + pos - k)) * DM + col; const f32x4 a = *(const f32x4*)st, b2 = *(const f32x4*)(st + 4);
                    uk[0] = a[0]; uk[1] = a[1]; uk[2] = a[2]; uk[3] = a[3]; uk[4] = b2[0]; uk[5] = b2[1]; uk[6] = b2[2]; uk[7] = b2[3]; }
                else {
#pragma unroll
                    for (int j = 0; j < 8; ++j) uk[j] = 0.f; } }
            const float* cw = p->conv_w + col;
#pragma unroll
            for (int j = 0; j < 8; ++j) r[j] = bb[j] * (cw[j] * u2[j] + cw[DM + j] * u1[j] + cw[2 * DM + j] * u0[j]) * siluf(gg[j]);
            *(u32x4*)(A2 + (size_t)row * DM + col) = pack8(r);
            if (pos >= (samp ? DS : SEQ) - 2) {
                float* d = p->out + (samp ? O_CVS : O_CVP) + ((size_t)bs * 2 + (pos - ((samp ? DS : SEQ) - 2))) * DM + col;
                *(f32x4*)d = (f32x4){u0[0], u0[1], u0[2], u0[3]}; *(f32x4*)(d + 4) = (f32x4){u0[4], u0[5], u0[6], u0[7]}; } }
    }
}

template <int K> __device__ __forceinline__ f32x4 skinny_acc(const bf16_t* A, const bf16_t* Wt, int ct, int rt, int kh, int lane, f32x4 acc) {
    const int fr = lane & 15, fq = lane >> 4;
    const bf16_t* ap = A + (size_t)(rt * 16 + fr) * K + kh * (K / 2) + fq * 8;
    const bf16_t* bp = Wt + (size_t)(ct * 16 + fr) * K + kh * (K / 2) + fq * 8;
#pragma unroll 1
    for (int k0 = 0; k0 < K / 2; k0 += 512) {
        bf16x8 a[16], b[16];
#pragma unroll
        for (int i = 0; i < 16; ++i) { a[i] = *(const bf16x8*)(ap + k0 + i * 32); b[i] = *(const bf16x8*)(bp + k0 + i * 32); }
#pragma unroll
        for (int i = 0; i < 16; ++i) acc = __builtin_amdgcn_mfma_f32_16x16x32_bf16(a[i], b[i], acc, 0, 0, 0);
    }
    return acc;
}
__device__ __forceinline__ void p4_sample(KP p, LAS unsigned char* lds, int blk, int wave, int lane) {
    const bf16_t* Z = (const bf16_t*)(p->ws + WS_Z); bf16_t* MB = (bf16_t*)(p->ws + WS_MB);
    const int ct = blk >> 1, rt = 4 * (blk & 1) + (wave & 3), kh = wave >> 2;
    const f32x4 z4 = (f32x4){0.f, 0.f, 0.f, 0.f};
    f32x4 a = skinny_acc<D_ATT>((const bf16_t*)(p->ws + WS_A1) + (size_t)NTOK_P * D_ATT, (const bf16_t*)(p->ws + WS_WATT), ct, rt, kh, lane, z4);
    f32x4 c = skinny_acc<DM>((const bf16_t*)(p->ws + WS_A2) + (size_t)NTOK_P * DM, (const bf16_t*)(p->ws + WS_WCONV), ct, rt, kh, lane, z4);
    LAS f32x4* red = (LAS f32x4*)lds;
    if (kh == 1) { red[(wave & 3) * 64 + lane] = a; red[256 + (wave & 3) * 64 + lane] = c; }
    __syncthreads();
    if (kh == 0) { a += red[(wave & 3) * 64 + lane]; c += red[256 + (wave & 3) * 64 + lane];
        const int n = ct * 16 + (lane & 15), fq = lane >> 4;
#pragma unroll
        for (int r = 0; r < 4; ++r) { const size_t row = (size_t)NTOK_P + rt * 16 + fq * 4 + r;
            const float l1 = __uint_as_float((unsigned)Z[row * N_IN + OFF_MERGE + n] << 16), l2 = __uint_as_float((unsigned)Z[row * N_IN + OFF_MERGE + DM + n] << 16);
            MB[row * DM + n] = (bf16_t)(cvt_pk_bf16(pg8::sigm(l1) * a[r] + pg8::sigm(l2) * c[r], 0.f) & 0xffffu); } }
    __syncthreads();
}
__device__ __forceinline__ void p5_sample(KP p, LAS unsigned char* lds, int blk, int wave, int lane) {
    const int ct = blk >> 1, rt = 4 * (blk & 1) + (wave & 3), kh = wave >> 2;
    f32x4 acc = skinny_acc<DM>((const bf16_t*)(p->ws + WS_MB) + (size_t)NTOK_P * DM, (const bf16_t*)(p->ws + WS_WOUT), ct, rt, kh, lane, (f32x4){0.f, 0.f, 0.f, 0.f});
    LAS f32x4* red = (LAS f32x4*)lds;
    if (kh == 1) red[(wave & 3) * 64 + lane] = acc;
    __syncthreads();
    if (kh == 0) { acc += red[(wave & 3) * 64 + lane];
        const int n = ct * 16 + (lane & 15), fq = lane >> 4;
#pragma unroll
        for (int r = 0; r < 4; ++r) { const size_t m = (size_t)rt * 16 + fq * 4 + r; (p->out + O_YS)[m * DM + n] = p->x_sample[m * DM + n] + acc[r]; } }
    __syncthreads();
}

constexpr int COPY_R_IN = 69504;
__device__ __forceinline__ void tail_copy(const pg8::CopySide& C, int c, int n, int tid) {
#pragma unroll 1
    for (int q = COPY_R_IN + c; q < pg8::CopySide::R2; q += 8 * n) {
        f32x4 v[8];
#pragma unroll
        for (int u = 0; u < 8; ++u) { const int qq = q + u * n; if (qq < pg8::CopySide::R2) { const float* s_; float* d_; C.rows(qq, s_, d_); v[u] = __builtin_nontemporal_load((const f32x4*)s_ + tid); } }
#pragma unroll
        for (int u = 0; u < 8; ++u) { const int qq = q + u * n; if (qq < pg8::CopySide::R2) { const float* s_; float* d_; C.rows(qq, s_, d_); __builtin_nontemporal_store(v[u], (f32x4*)d_ + tid); } }
    }
}

#define XB_TMO      128
#define XB_XCNT(j)  (256  + 64 * (j))
#define XB_XSUB(j)  (1280 + 64 * (j))
#define XB_XGEN(j)  (2304 + 64 * (j))
#define XB_TOP      3328
#define XB_TOPGEN   3392
#define XCD_BAR_WORDS 3456
#define XB_SPIN_CAP (1u << 22)
__device__ __forceinline__ unsigned xb_ld(unsigned* q)              { return __hip_atomic_load(q, __ATOMIC_RELAXED, __HIP_MEMORY_SCOPE_AGENT); }
__device__ __forceinline__ unsigned xb_add(unsigned* q, unsigned v) { return __hip_atomic_fetch_add(q, v, __ATOMIC_RELAXED, __HIP_MEMORY_SCOPE_AGENT); }
__device__ __forceinline__ unsigned xb_xcc_id() { return (unsigned)__builtin_amdgcn_s_getreg((3 << 11) | 20) & 0xFu; }
#define XB_SPIN(cond, bar) do { unsigned _sp = 0; while (cond) { __builtin_amdgcn_s_sleep(1); \
    if ((++_sp & 255u) == 0u) { if (xb_ld(&(bar)[XB_TMO])) break; if (_sp > XB_SPIN_CAP) { atomicAdd(&(bar)[XB_TMO], 1u); break; } } } } while (0)
__device__ __forceinline__ void xcd_barrier_complete(unsigned* bar, unsigned x, unsigned& nloc, unsigned& nx) {
    const unsigned G = gridDim.x;
    unsigned sum, cnt, mine, sp = 0u;
    for (;;) {
        sum = 0u; cnt = 0u; mine = 0u;
#pragma unroll
        for (unsigned j = 0; j < 16; ++j) { const unsigned c = xb_ld(&bar[XB_XCNT(j)]); sum += c; cnt += (c > 0u) ? 1u : 0u; mine = (j == x) ? c : mine; }
        if (sum == G) break;
        __builtin_amdgcn_s_sleep(1);
        if ((++sp & 255u) == 0u) { if (xb_ld(&bar[XB_TMO])) break; if (sp > XB_SPIN_CAP) { atomicAdd(&bar[XB_TMO], 1u); break; } }
    }
    nloc = mine > 0u ? mine : 1u; nx = cnt > 0u ? cnt : 1u;
}
__device__ __forceinline__ void xcd_barrier(unsigned* bar, unsigned x, volatile LAS unsigned* st) {
    asm volatile("s_waitcnt vmcnt(0)" ::: "memory");
    __syncthreads();
    if (threadIdx.x == 0) {
        __builtin_amdgcn_s_waitcnt(0);
        unsigned nloc = st[0], nx = st[1];
        if (nloc == 0u) { xcd_barrier_complete(bar, x, nloc, nx); st[0] = nloc; st[1] = nx; }
        const unsigned old = xb_add(&bar[XB_XSUB(x)], 1u);
        const unsigned gen = old / nloc;
        if (old + 1u == (gen + 1u) * nloc) {
            __builtin_amdgcn_fence(__ATOMIC_RELEASE, "agent");
            asm volatile("s_waitcnt vmcnt(0)" ::: "memory");
            const unsigned og = xb_add(&bar[XB_TOP], 1u);
            const unsigned tg = og / nx;
            if (og + 1u == (tg + 1u) * nx) xb_add(&bar[XB_TOPGEN], 1u);
            else XB_SPIN(xb_ld(&bar[XB_TOPGEN]) == tg, bar);
            __builtin_amdgcn_fence(__ATOMIC_ACQUIRE, "agent");
            xb_add(&bar[XB_XGEN(x)], 1u);
            asm volatile("s_waitcnt vmcnt(0)" ::: "memory");
        } else {
            XB_SPIN(xb_ld(&bar[XB_XGEN(x)]) == gen, bar);
            __builtin_amdgcn_fence(__ATOMIC_ACQUIRE, "agent");
            asm volatile("s_waitcnt vmcnt(0)" ::: "memory");
        }
    }
    __syncthreads();
}

#ifndef N_LAUNCHES
#define N_LAUNCHES 1
#endif
#ifndef PROBE_REP_PHASE
#define PROBE_REP_PHASE -1
#endif
#define REP(k) ((k) == PROBE_REP_PHASE ? 2 : 1)
struct KArgs { Params p; int ph_lo, ph_hi, use_cg, pad; };
__global__ void __launch_bounds__(NT, 2) fwd_mega(KArgs a_unused) {
    typedef const __attribute__((address_space(4))) KArgs* KA;
    KA ka = (KA)__builtin_amdgcn_kernarg_segment_ptr();
    KP p = (KP)ka;
    const int lo = ka->ph_lo, hi = ka->ph_hi, use_cg = ka->use_cg;
#define RELOAD() asm volatile("" : "+s"(p))
#define IN(k) (lo <= (k) && (k) < hi)
#define GSYNC(k) do { if (IN(k) && IN((k) + 1)) { if (use_cg) { asm volatile("s_waitcnt vmcnt(0)" ::: "memory"); __builtin_amdgcn_fence(__ATOMIC_RELEASE, "agent"); grid.sync(); __builtin_amdgcn_fence(__ATOMIC_ACQUIRE, "agent"); } \
        else xcd_barrier((unsigned*)(p->ws + WS_CTL), xcc, (volatile LAS unsigned*)(lds + XB_LDS_OFF)); } RELOAD(); } while (0)
    extern __shared__ __attribute__((aligned(16))) unsigned char lds_raw[];
    LAS unsigned char* lds = (LAS unsigned char*)lds_raw;
    cg::grid_group grid = cg::this_grid();
    const int tid = threadIdx.x, lane = tid & 63, wave = __builtin_amdgcn_readfirstlane(tid >> 6), G = gridDim.x;
    const unsigned xcc = xb_xcc_id();
    if (N_LAUNCHES == 1) {
        if (tid < 2) ((volatile LAS unsigned*)(lds + XB_LDS_OFF))[tid] = 0u;
        __syncthreads();
        if (tid == 0) (void)xb_add((unsigned*)(p->ws + WS_CTL) + XB_XCNT(xcc), 1u);
    }
    if (IN(0)) for (int rep = 0; rep < REP(0); ++rep) {
    p0_rope(p, G, tid);
    p0_rmsnorm(p, G, wave, lane);
    p0_transpose(p->w_in, (bf16_t*)(p->ws + WS_WIN), DM, N_IN, (LAS float*)lds, G, tid);
    p0_transpose(p->w_att, (bf16_t*)(p->ws + WS_WATT), D_ATT, DM, (LAS float*)lds, G, tid);
    p0_transpose(p->w_conv, (bf16_t*)(p->ws + WS_WCONV), DM, DM, (LAS float*)lds, G, tid);
    p0_transpose(p->w_out, (bf16_t*)(p->ws + WS_WOUT), DM, DM, (LAS float*)lds, G, tid);
    }
    GSYNC(0);
    if (IN(1)) { pg8::Gemm g{(const bf16_t*)(p->ws + WS_XN), (const bf16_t*)(p->ws + WS_WIN), M_PAD, N_IN, DM}; pg8::StaticOrder S; S.init(M_PAD, N_IN, G, (int)blockIdx.x);
      pg8::EpiZ E{(bf16_t*)(p->ws + WS_Z), N_IN};
      pg8::CopySide C{p->cache[0], p->cache[1], p->cache[2], p->out + O_KVS0, p->out + O_KVS1, p->out + O_KVS2, (int)blockIdx.x, G, COPY_R_IN};
      pg8::gemm_phase<pg8::EpiZ, pg8::StaticOrder, pg8::CopySide>(lds, g, S, E, nullptr, C, pg8::STAGE_BYTES);
      { const int nlast = ((M_PAD / 256) * (N_IN / 256)) % G;
        if ((int)blockIdx.x >= nlast) tail_copy(C, (int)blockIdx.x - nlast, G - nlast, tid); } }
    GSYNC(1);
    if (IN(2)) for (int rep = 0; rep < REP(2); ++rep) {
    if (tid < 384) ((LAS float*)(lds + NW_OFF))[tid] = p->k_norm_w[tid]; else if (tid < 768 - 384 + 384 && tid - 384 < 128) ((LAS float*)(lds + NW_OFF))[384 + (tid - 384)] = p->q_norm_w[tid - 384];
    if (tid < 256) ((LAS float*)(lds + NW_OFF))[512 + tid] = p->q_norm_w[128 + tid];
    __syncthreads();
    for (int rp = 0; rp < REP(20); ++rp)
    { int a2pass = 0;
      for (int it = blockIdx.x; it < 256; it += G)
#pragma unroll 1
          for (int sub = 0; sub < 2; ++sub) {
              int cg, cb, cr, ch, cq, cn;
              if (sub == 1) { cg = 2; cb = it >> 7; cr = (it >> 3) & 15; ch = it & 7; cq = 0; cn = 4; }
              else if (it < 128) { const int st = it >> 3; cg = 0; cb = st >> 3; cr = 0; ch = st & 7; cq = (it & 7) * 8; cn = 8; }
              else { const int j = it - 128, st = j >> 1; cg = 1; cb = st >> 5; cr = (st >> 3) & 3; ch = st & 7; cq = (j & 1) * 8; cn = 8; }
              attn_prompt_chunk(p, lds, cg, cb, cr, ch, cq, cn, tid, wave, lane);
              const int np_ = sub ? 4 : 5; p3_rows<false, true>(p, G, wave, lane, a2pass, a2pass + np_); a2pass += np_; }
      p3_rows<false, true>(p, G, wave, lane, a2pass, 1 << 20); }
    for (int rp = 0; rp < REP(21); ++rp)
    for (int it = blockIdx.x; it < 768; it += G) attn_sample_item(p, lds, it, tid, wave, lane);
    }
    GSYNC(2);
    if (IN(3)) for (int rep = 0; rep < REP(3); ++rep) p3_rows<true, false>(p, G, wave, lane, 0, 1 << 20);
    GSYNC(3);
    if (IN(4)) { pg8::Gemm g{(const bf16_t*)(p->ws + WS_A1), (const bf16_t*)(p->ws + WS_WATT), NTOK_P, DM, D_ATT}; pg8::StaticOrder S; S.init(NTOK_P, DM, G, (int)blockIdx.x);
      pg8::EpiT E{(bf16_t*)(p->ws + WS_T), DM, (const bf16_t*)(p->ws + WS_Z), N_IN, OFF_MERGE};
      pg8::gemm_phase<pg8::EpiT, pg8::StaticOrder>(lds, g, S, E, nullptr); }
    if (N_LAUNCHES != 1) { GSYNC(4); } else { asm volatile("s_waitcnt vmcnt(0)" ::: "memory"); RELOAD(); }
    if (IN(5)) { pg8::Gemm g{(const bf16_t*)(p->ws + WS_A2), (const bf16_t*)(p->ws + WS_WCONV), NTOK_P, DM, DM}; pg8::StaticOrder S; S.init(NTOK_P, DM, G, (int)blockIdx.x);
      pg8::EpiM E{(const bf16_t*)(p->ws + WS_T), DM, (bf16_t*)(p->ws + WS_MB), DM, (const bf16_t*)(p->ws + WS_Z), N_IN, OFF_MERGE + DM};
      pg8::gemm_phase<pg8::EpiM, pg8::StaticOrder>(lds, g, S, E, nullptr);
      if (G == 256) p4_sample(p, lds, (int)blockIdx.x, wave, lane); else if (blockIdx.x == 0) { for (int bk = 0; bk < 256; ++bk) p4_sample(p, lds, bk, wave, lane); } }
    GSYNC(5);
    if (IN(6)) { pg8::Gemm g{(const bf16_t*)(p->ws + WS_MB), (const bf16_t*)(p->ws + WS_WOUT), NTOK_P, DM, DM}; pg8::StaticOrder S; S.init(NTOK_P, DM, G, (int)blockIdx.x);
      pg8::EpiY E{p->x_prompt, p->x_sample, p->out + O_YP, p->out + O_YS, NTOK_P, NTOK_S, DM};
      pg8::gemm_phase<pg8::EpiY, pg8::StaticOrder>(lds, g, S, E, nullptr);
      if (G == 256) p5_sample(p, lds, (int)blockIdx.x, wave, lane); else if (blockIdx.x == 0) { for (int bk = 0; bk < 256; ++bk) p5_sample(p, lds, bk, wave, lane); } }
}

extern "C" void kernel_launch(void* const* d_in, const int* in_sizes, int n_in, void* d_out, int out_size, void* d_ws, size_t ws_size, hipStream_t stream) {
    static int grid = 0;
    if (grid == 0) {
        if (n_in != 14 || (size_t)out_size != O_END || ws_size < WS_END) { fprintf(stderr, "kernel_launch: unexpected shapes (n_in %d out %d ws %zu)\n", n_in, out_size, ws_size); grid = -1; return; }
        int dev = 0, cus = 0, per_cu = 0;
        (void)hipGetDevice(&dev); (void)hipDeviceGetAttribute(&cus, hipDeviceAttributeMultiprocessorCount, dev);
        if (hipFuncSetAttribute((const void*)fwd_mega, hipFuncAttributeMaxDynamicSharedMemorySize, LDS_BYTES) != hipSuccess) { fprintf(stderr, "kernel_launch: hipFuncSetAttribute failed\n"); grid = -1; return; }
        if (hipOccupancyMaxActiveBlocksPerMultiprocessor(&per_cu, (const void*)fwd_mega, NT, LDS_BYTES) != hipSuccess || per_cu < 1) { fprintf(stderr, "kernel_launch: occupancy query says %d\n", per_cu); per_cu = 1; }
        (void)hipGetLastError();
        grid = cus * 1;
    }
    if (grid < 0) return;
    KArgs a{};
    Params& p = a.p;
    p.x_prompt = (const float*)d_in[0]; p.x_sample = (const float*)d_in[1]; p.cache[0] = (const float*)d_in[2]; p.cache[1] = (const float*)d_in[3]; p.cache[2] = (const float*)d_in[4];
    p.state_conv = (const float*)d_in[5]; p.norm_w = (const float*)d_in[6]; p.w_in = (const float*)d_in[7]; p.q_norm_w = (const float*)d_in[8]; p.k_norm_w = (const float*)d_in[9];
    p.conv_w = (const float*)d_in[10]; p.w_att = (const float*)d_in[11]; p.w_conv = (const float*)d_in[12]; p.w_out = (const float*)d_in[13]; p.out = (float*)d_out; p.ws = (unsigned char*)d_ws;
    if (N_LAUNCHES == 1) {
        a.ph_lo = 0; a.ph_hi = 7;
        (void)hipMemsetAsync((char*)d_ws + WS_CTL, 0, 16384, stream);
        void* args[] = {&a};
        hipError_t e = hipLaunchCooperativeKernel((const void*)fwd_mega, dim3(grid), dim3(NT), args, LDS_BYTES, stream);
        if (e != hipSuccess) fprintf(stderr, "kernel_launch: cooperative launch failed: %s (grid %d)\n", hipGetErrorString(e), grid);
    } else {
        for (int k = 0; k < 7; ++k) { a.ph_lo = k; a.ph_hi = k + 1; hipLaunchKernelGGL(fwd_mega, dim3(grid), dim3(NT), LDS_BYTES, stream, a); }
    }
}
```
